# Optimizing an MI355X kernel written in HIP

```python
import math
import jax, jax.numpy as jnp
from jax import lax
import numpy as np

D_MODEL = 1024
BATCH = 8
SEQ = 2048
DEPTH = 1

BLK = 128
WINDOW = 128
A_HEADS = 8
A_KV_HEADS = 2
A_GROUP = A_HEADS // A_KV_HEADS
A_HEAD_DIM = 64
B_HEADS = 8
B_NOPE_DIM = 64
B_ROPE_DIM = 32
B_V_DIM = 64
Q_RANK = 256
KV_RANK = 128
ROPE_THETA = 10000.0
NUM_BUCKETS = 32
MAX_DISTANCE = 128
N_EXPERTS = 16
EXPERT_FF = 512
CAPACITY_FACTOR = 2
PLE_DIM = 256
EPS = 1e-6

A_Q_COLS = A_HEADS * A_HEAD_DIM
A_K_COLS = A_KV_HEADS * A_HEAD_DIM
A_V_COLS = A_KV_HEADS * A_HEAD_DIM
B_CQ_COLS = Q_RANK
B_CKV_COLS = KV_RANK
B_KR_COLS = B_ROPE_DIM
OFF_AQ = 0
OFF_AK = OFF_AQ + A_Q_COLS
OFF_AV = OFF_AK + A_K_COLS
OFF_BCQ = OFF_AV + A_V_COLS
OFF_BCKV = OFF_BCQ + B_CQ_COLS
OFF_BKR = OFF_BCKV + B_CKV_COLS
IN_COLS = OFF_BKR + B_KR_COLS
A_OUT = A_HEADS * A_HEAD_DIM
B_OUT = B_HEADS * B_V_DIM
MIX_WIDTH = A_OUT + B_OUT

kernel_name = "hymba_swa_mla_ec_moe_encoder"


def rms_norm(x, g):
    xf = x.astype(jnp.float32)
    y = xf * lax.rsqrt(jnp.mean(xf * xf, axis=-1, keepdims=True) + EPS)
    return (y * g.astype(jnp.float32)).astype(x.dtype)


def t5_bucket(rel):
    half = NUM_BUCKETS // 2
    ret = jnp.where(rel > 0, half, 0)
    n = jnp.abs(rel)
    max_exact = half // 2
    is_small = n < max_exact
    nf = jnp.maximum(n, 1).astype(jnp.float32)
    large = max_exact + (jnp.log(nf / max_exact) / math.log(MAX_DISTANCE / max_exact)
                         * (half - max_exact)).astype(jnp.int32)
    large = jnp.minimum(large, half - 1)
    return ret + jnp.where(is_small, n, large)


def window_gqa(q, k, v, sink, rel_bias):
    B, S = q.shape[0], q.shape[1]
    nb = S // BLK
    qb = q.reshape(B, nb, BLK, A_KV_HEADS, A_GROUP, A_HEAD_DIM)
    pad = ((0, 0), (BLK, BLK), (0, 0), (0, 0))

    def band(t):
        tp = jnp.pad(t, pad).reshape(B, nb + 2, BLK, A_KV_HEADS, A_HEAD_DIM)
        return jnp.concatenate([tp[:, :-2], tp[:, 1:-1], tp[:, 2:]], axis=2)

    kb, vb = band(k), band(v)
    qi = jnp.arange(BLK)[:, None]
    kj = jnp.arange(3 * BLK)[None, :]
    rel = kj - BLK - qi
    bias = rel_bias.astype(jnp.float32)[t5_bucket(rel)]
    bias = bias.transpose(2, 0, 1).reshape(A_KV_HEADS, A_GROUP, BLK, 3 * BLK)
    key_idx = jnp.arange(nb)[:, None] * BLK - BLK + jnp.arange(3 * BLK)[None, :]
    in_range = (key_idx >= 0) & (key_idx < S)
    valid = (jnp.abs(rel) <= WINDOW)[None] & in_range[:, None, :]

    scale = A_HEAD_DIM ** -0.5
    s = jnp.einsum('bnqhgd,bnkhd->bnhgqk', qb, kb).astype(jnp.float32) * scale + bias[None, None]
    s = jnp.where(valid[None, :, None, None], s, jnp.float32(-1e30))
    sink_l = sink.astype(jnp.float32).reshape(A_KV_HEADS, A_GROUP)[None, None, :, :, None, None]
    m = jnp.maximum(jnp.max(s, axis=-1, keepdims=True), sink_l)
    e = jnp.exp(s - m)
    denom = jnp.sum(e, axis=-1, keepdims=True) + jnp.exp(sink_l - m)
    pr = (e / denom).astype(v.dtype)
    o = jnp.einsum('bnhgqk,bnkhd->bnqhgd', pr, vb)
    return o.reshape(B, S, A_OUT)


def rope(t, cos, sin):
    half = t.shape[-1] // 2
    t1, t2 = t[..., :half], t[..., half:]
    return jnp.concatenate([t1 * cos - t2 * sin, t1 * sin + t2 * cos], axis=-1)


def mla(c_q, c_kv, k_rope, positions, g_cq, g_ckv, w_uq, w_ukv):
    B, S = c_q.shape[0], c_q.shape[1]
    q = (rms_norm(c_q, g_cq) @ w_uq).reshape(B, S, B_HEADS, B_NOPE_DIM + B_ROPE_DIM)
    kv = (rms_norm(c_kv, g_ckv) @ w_ukv).reshape(B, S, B_HEADS, B_NOPE_DIM + B_V_DIM)
    qn, qr = q[..., :B_NOPE_DIM], q[..., B_NOPE_DIM:]
    kn, v = kv[..., :B_NOPE_DIM], kv[..., B_NOPE_DIM:]

    inv_freq = 1.0 / (ROPE_THETA ** (jnp.arange(0, B_ROPE_DIM, 2, dtype=jnp.float32) / B_ROPE_DIM))
    ang = positions.astype(jnp.float32)[..., None] * inv_freq
    cos, sin = jnp.cos(ang).astype(q.dtype), jnp.sin(ang).astype(q.dtype)
    qr = rope(qr, cos[:, :, None], sin[:, :, None])
    kr = rope(k_rope, cos, sin)

    nb = S // BLK
    qn_b = qn.reshape(B, nb, BLK, B_HEADS, B_NOPE_DIM).transpose(1, 0, 2, 3, 4)
    qr_b = qr.reshape(B, nb, BLK, B_HEADS, B_ROPE_DIM).transpose(1, 0, 2, 3, 4)
    scale = (B_NOPE_DIM + B_ROPE_DIM) ** -0.5

    def attend(blk):
        qn_i, qr_i = blk
        s = (jnp.einsum('bqhd,bkhd->bhqk', qn_i, kn)
             + jnp.einsum('bqhd,bkd->bhqk', qr_i, kr)).astype(jnp.float32) * scale
        pr = jax.nn.softmax(s, axis=-1).astype(v.dtype)
        return jnp.einsum('bhqk,bkhd->bqhd', pr, v)

    o = lax.map(attend, (qn_b, qr_b))
    return o.transpose(1, 0, 2, 3, 4).reshape(B, S, B_OUT)


def ec_moe(h, w_router, w_gate, w_up, w_down):
    B, S, _ = h.shape
    cap = CAPACITY_FACTOR * S // N_EXPERTS
    aff = jax.nn.softmax((h @ w_router).astype(jnp.float32), axis=-1)
    vals, idx = lax.top_k(aff.transpose(0, 2, 1), cap)
    bidx = jnp.arange(B)[:, None, None]
    xg = h[bidx, idx]
    g = jnp.einsum('becd,edf->becf', xg, w_gate)
    u = jnp.einsum('becd,edf->becf', xg, w_up)
    o = jnp.einsum('becf,efd->becd', jax.nn.silu(g) * u, w_down)
    o = o * vals[..., None].astype(h.dtype)
    return jnp.zeros_like(h).at[bidx, idx].add(o)


def setup_inputs(seed: int = 0) -> dict:
    key = jax.random.key(seed)
    ks = jax.random.split(key, 24)
    f32 = jnp.float32

    def nrm(k, shape, fan_in):
        return jax.random.normal(k, shape, f32) * (fan_in ** -0.5)

    def gain(k, shape):
        return 1.0 + 0.05 * jax.random.normal(k, shape, f32)

    x = jax.random.normal(ks[0], (BATCH, SEQ, D_MODEL), f32)
    p = jax.random.normal(ks[1], (DEPTH, BATCH, SEQ, PLE_DIM), f32)
    offs = jax.random.randint(ks[2], (BATCH, 1), 0, 1024, dtype=jnp.int32)
    positions = jnp.arange(SEQ, dtype=jnp.int32)[None, :] + offs
    return {
        "x": x,
        "p": p,
        "positions": positions,
        "rel_bias": 0.5 * jax.random.normal(ks[3], (NUM_BUCKETS, A_HEADS), f32),
        "norm_mix_g": gain(ks[4], (DEPTH, D_MODEL)),
        "w_in": nrm(ks[5], (DEPTH, D_MODEL, IN_COLS), D_MODEL),
        "sink": 0.5 * jax.random.normal(ks[6], (DEPTH, A_HEADS), f32),
        "g_cq": gain(ks[7], (DEPTH, Q_RANK)),
        "g_ckv": gain(ks[8], (DEPTH, KV_RANK)),
        "w_uq": nrm(ks[9], (DEPTH, Q_RANK, B_HEADS * (B_NOPE_DIM + B_ROPE_DIM)), Q_RANK),
        "w_ukv": nrm(ks[10], (DEPTH, KV_RANK, B_HEADS * (B_NOPE_DIM + B_V_DIM)), KV_RANK),
        "g_out_a": gain(ks[11], (DEPTH, A_OUT)),
        "g_out_b": gain(ks[12], (DEPTH, B_OUT)),
        "w_out": nrm(ks[13], (DEPTH, MIX_WIDTH, D_MODEL), MIX_WIDTH),
        "norm_ffn_g": gain(ks[14], (DEPTH, D_MODEL)),
        "w_router": nrm(ks[15], (DEPTH, D_MODEL, N_EXPERTS), D_MODEL),
        "w_e_gate": nrm(ks[16], (DEPTH, N_EXPERTS, D_MODEL, EXPERT_FF), D_MODEL),
        "w_e_up": nrm(ks[17], (DEPTH, N_EXPERTS, D_MODEL, EXPERT_FF), D_MODEL),
        "w_e_down": nrm(ks[18], (DEPTH, N_EXPERTS, EXPERT_FF, D_MODEL), EXPERT_FF),
        "norm_ple_g": gain(ks[19], (DEPTH, D_MODEL)),
        "w_ple_gate": nrm(ks[20], (DEPTH, D_MODEL, D_MODEL), D_MODEL),
        "w_ple_proj": nrm(ks[21], (DEPTH, PLE_DIM, D_MODEL), PLE_DIM),
        "final_norm_g": gain(ks[22], (D_MODEL,)),
    }


def reference(x, p, positions, rel_bias, norm_mix_g, w_in, sink, g_cq, g_ckv, w_uq, w_ukv,
              g_out_a, g_out_b, w_out, norm_ffn_g, w_router, w_e_gate, w_e_up, w_e_down,
              norm_ple_g, w_ple_gate, w_ple_proj, final_norm_g):
    B, S, _ = x.shape
    for i in range(DEPTH):
        h = rms_norm(x, norm_mix_g[i])
        z = h @ w_in[i]
        qa = z[..., OFF_AQ:OFF_AK].reshape(B, S, A_HEADS, A_HEAD_DIM)
        ka = z[..., OFF_AK:OFF_AV].reshape(B, S, A_KV_HEADS, A_HEAD_DIM)
        va = z[..., OFF_AV:OFF_BCQ].reshape(B, S, A_KV_HEADS, A_HEAD_DIM)
        c_q = z[..., OFF_BCQ:OFF_BCKV]
        c_kv = z[..., OFF_BCKV:OFF_BKR]
        k_rope = z[..., OFF_BKR:IN_COLS]
        ya = window_gqa(qa, ka, va, sink[i], rel_bias)
        yb = mla(c_q, c_kv, k_rope, positions, g_cq[i], g_ckv[i], w_uq[i], w_ukv[i])
        y = jnp.concatenate([rms_norm(ya, g_out_a[i]), rms_norm(yb, g_out_b[i])], axis=-1)
        x = x + y @ w_out[i]
        h = rms_norm(x, norm_ffn_g[i])
        x = x + ec_moe(h, w_router[i], w_e_gate[i], w_e_up[i], w_e_down[i])
        gate = jax.nn.sigmoid(rms_norm(x, norm_ple_g[i]) @ w_ple_gate[i])
        x = x + gate * (p[i] @ w_ple_proj[i])
    return rms_norm(x, final_norm_g)
```

```cpp
#include <hip/hip_runtime.h>
#include <hip/hip_bf16.h>
#include <cstdio>
#include <cstdint>

constexpr int BATCH = 8, SEQ = 2048, DM = 1024, T = BATCH * SEQ;
constexpr int IN_COLS = 1184, IN_PAD = 1280;
constexpr int NE = 16, FF = 512, CAP = 256, NBE = BATCH * NE;
constexpr int PLE = 256;
constexpr float EPS = 1e-6f;
constexpr float LOG2E = 1.4426950408889634f;

namespace pg8 {
#define PG8_LAS __attribute__((address_space(3)))
typedef unsigned short bf16_t;
typedef short bf16x8 __attribute__((ext_vector_type(8)));
typedef float f32x4 __attribute__((ext_vector_type(4)));
typedef unsigned u32x4 __attribute__((ext_vector_type(4)));
constexpr int BM = 256, BK = 64, HALF = 128, HTB = HALF * BK * 2  , STAGE_BYTES = 8 * HTB, NXCD = 8, WGM = 8;

__host__ __device__ __forceinline__ int lds_byte(int r, int c) { const int st = (r >> 4) * 2 + (c >> 5), rr = r & 15, cc = c & 31, ob = rr * 64 + cc * 2; return st * 1024 + (ob ^ (((ob >> 9) & 1) << 5)); }
__host__ __device__ __forceinline__ void stage_rc(int b, int& R, int& C) { const int st = b / 1024, sb = b % 1024, swz = sb ^ (((sb >> 9) & 1) << 5); R = (st >> 1) * 16 + swz / 64; C = (st & 1) * 32 + (swz % 64) / 2; }
__host__ __device__ __forceinline__ int perm32(int rho) { const int n = rho >> 4, i = rho & 15; return 8 * (i >> 2) + 4 * n + (i & 3); }

struct Unit { int pm, pn; };
struct Gemm { const bf16_t* A; const bf16_t* Bt; int M, N, K; };

struct StaticOrder {
    int nM, nN, nwg, G, c, bexp;
    __host__ __device__ void init(int M, int N, int G_, int c_) { nM = M / BM; nN = N / BM; nwg = nM * nN; G = G_; c = c_; bexp = 0; }
    __host__ __device__ bool next(int i, Unit& u) const {
        const long L = (long)i * G + c; if (L >= nwg) return false;
        int wgid = (int)L; { const int q = nwg / NXCD, r = nwg % NXCD, xcd = wgid % NXCD, off = wgid / NXCD; wgid = (xcd < r ? xcd * (q + 1) : r * (q + 1) + (xcd - r) * q) + off; }
        const int nig = WGM * nN, gid = wgid / nig, fm = gid * WGM, gsz = (nM - fm) < WGM ? (nM - fm) : WGM;
        u.pm = fm + ((wgid % nig) % gsz); u.pn = (wgid % nig) / gsz; return true;
    }
    __device__ __forceinline__ int btile(const Unit& u) const { return bexp ? (u.pm & (bexp - 1)) * nN + u.pn : u.pn; }
    __device__ __forceinline__ void a_ready(const Unit&) const {}
    __device__ __forceinline__ void done(const Unit&) const {}
};


__device__ __forceinline__ unsigned cvt_pk_bf16(float lo, float hi) { unsigned r; asm volatile("v_cvt_pk_bf16_f32 %0, %1, %2" : "=v"(r) : "v"(lo), "v"(hi)); return r; }
__device__ __forceinline__ u32x4 pack8(const f32x4 v0, const f32x4 v1) { u32x4 w; w.x = cvt_pk_bf16(v0[0], v0[1]); w.y = cvt_pk_bf16(v0[2], v0[3]); w.z = cvt_pk_bf16(v1[0], v1[1]); w.w = cvt_pk_bf16(v1[2], v1[3]); return w; }
__device__ __forceinline__ float bflo(unsigned w) { return __builtin_bit_cast(float, w << 16); }
__device__ __forceinline__ float bfhi(unsigned w) { return __builtin_bit_cast(float, w & 0xffff0000u); }

struct EpiZ {
    static constexpr bool PERM = true, AFTER_DRAIN = false;
    bf16_t* QA; bf16_t* KVA; float* ZB;
    __device__ __forceinline__ void operator()(const f32x4 (&acc)[2][2][4][2], const Unit& u, int wr, int wc, int fr, int fq) const {
        const int row0 = u.pm * BM + wr * 64 + fr, c8 = wc * 32 + 8 * fq;
#pragma unroll
        for (int ai = 0; ai < 2; ++ai)
#pragma unroll
            for (int m = 0; m < 4; ++m) { const size_t row = (size_t)(row0 + ai * HALF + m * 16);
#pragma unroll
                for (int bj = 0; bj < 2; ++bj) { const int col = bj * HALF + c8; const f32x4 v0 = acc[ai][bj][m][0], v1 = acc[ai][bj][m][1];
                    if (u.pn < 2) *(u32x4*)(QA + row * 512 + u.pn * 256 + col) = pack8(v0, v1);
                    else if (u.pn == 2) *(u32x4*)(KVA + row * 256 + col) = pack8(v0, v1);
                    else if (u.pn == 3) { float* p = ZB + row * 416 + col; *(f32x4*)p = v0; *(f32x4*)(p + 4) = v1; }
                    else if (col < 160) { float* p = ZB + row * 416 + 256 + col; *(f32x4*)p = v0; *(f32x4*)(p + 4) = v1; } } }
    }
};
template <int ldc> struct EpiBf {
    static constexpr bool PERM = true, AFTER_DRAIN = false;
    bf16_t* O;
    __device__ __forceinline__ void operator()(const f32x4 (&acc)[2][2][4][2], const Unit& u, int wr, int wc, int fr, int fq) const {
        const int row0 = u.pm * BM + wr * 64 + fr, c8 = u.pn * BM + wc * 32 + 8 * fq;
#pragma unroll
        for (int ai = 0; ai < 2; ++ai)
#pragma unroll
            for (int m = 0; m < 4; ++m) { bf16_t* rowp = O + (size_t)(row0 + ai * HALF + m * 16) * ldc + c8;
#pragma unroll
                for (int bj = 0; bj < 2; ++bj) *(u32x4*)(rowp + bj * HALF) = pack8(acc[ai][bj][m][0], acc[ai][bj][m][1]); }
    }
};
struct EpiRes {
    static constexpr bool PERM = false, AFTER_DRAIN = false;
    const float* base; float* out;
    __device__ __forceinline__ void operator()(const f32x4 (&acc)[2][2][4][2], const Unit& u, int wr, int wc, int fr, int fq) const {
        const int row0 = u.pm * BM + wr * 64 + fr, c4 = u.pn * BM + wc * 32 + 4 * fq;
#pragma unroll
        for (int ai = 0; ai < 2; ++ai)
#pragma unroll
            for (int m = 0; m < 4; ++m) { const size_t off = (size_t)(row0 + ai * HALF + m * 16) * 1024 + c4;
#pragma unroll
                for (int bj = 0; bj < 2; ++bj)
#pragma unroll
                    for (int n = 0; n < 2; ++n) { const f32x4 b = *(const f32x4*)(base + off + bj * HALF + n * 16); *(f32x4*)(out + off + bj * HALF + n * 16) = b + acc[ai][bj][m][n]; } }
    }
};
struct EpiSwiGLU {
    static constexpr bool PERM = true, AFTER_DRAIN = false;
    bf16_t* ACT;
    __device__ __forceinline__ void operator()(const f32x4 (&acc)[2][2][4][2], const Unit& u, int wr, int wc, int fr, int fq) const {
        const int row0 = u.pm * BM + wr * 64 + fr, c8 = u.pn * HALF + wc * 32 + 8 * fq;
#pragma unroll
        for (int ai = 0; ai < 2; ++ai)
#pragma unroll
            for (int m = 0; m < 4; ++m) { f32x4 r[2];
#pragma unroll
                for (int n = 0; n < 2; ++n)
#pragma unroll
                    for (int i = 0; i < 4; ++i) { const float g = acc[ai][0][m][n][i], up = acc[ai][1][m][n][i]; r[n][i] = g * __builtin_amdgcn_rcpf(1.0f + __expf(-g)) * up; }
                *(u32x4*)(ACT + (size_t)(row0 + ai * HALF + m * 16) * 512 + c8) = pack8(r[0], r[1]); }
    }
};
struct EpiDown {
    static constexpr bool PERM = true, AFTER_DRAIN = false;
    bf16_t* OB; const float* VAL;
    __device__ __forceinline__ void operator()(const f32x4 (&acc)[2][2][4][2], const Unit& u, int wr, int wc, int fr, int fq) const {
        const int row0 = u.pm * BM + wr * 64 + fr, c8 = u.pn * BM + wc * 32 + 8 * fq;
#pragma unroll
        for (int ai = 0; ai < 2; ++ai)
#pragma unroll
            for (int m = 0; m < 4; ++m) { const int row = row0 + ai * HALF + m * 16; const float s = VAL[row]; bf16_t* rowp = OB + (size_t)row * 1024 + c8;
#pragma unroll
                for (int bj = 0; bj < 2; ++bj) *(u32x4*)(rowp + bj * HALF) = pack8(acc[ai][bj][m][0] * s, acc[ai][bj][m][1] * s); }
    }
};
struct EpiPle {
    static constexpr bool PERM = true, AFTER_DRAIN = false;
    float* out; const bf16_t* PROJ;
    __device__ __forceinline__ void operator()(const f32x4 (&acc)[2][2][4][2], const Unit& u, int wr, int wc, int fr, int fq) const {
        const int row0 = u.pm * BM + wr * 64 + fr, c8 = u.pn * BM + wc * 32 + 8 * fq;
#pragma unroll
        for (int ai = 0; ai < 2; ++ai)
#pragma unroll
            for (int m = 0; m < 4; ++m) { const size_t off = (size_t)(row0 + ai * HALF + m * 16) * 1024 + c8;
#pragma unroll
                for (int bj = 0; bj < 2; ++bj) { float* op = out + off + bj * HALF; const u32x4 pw = *(const u32x4*)(PROJ + off + bj * HALF);
                    const f32x4 x0 = *(const f32x4*)op, x1 = *(const f32x4*)(op + 4); const f32x4 a0 = acc[ai][bj][m][0], a1 = acc[ai][bj][m][1];
                    f32x4 g0, g1;
#pragma unroll
                    for (int i = 0; i < 4; ++i) { g0[i] = __builtin_amdgcn_rcpf(1.0f + __expf(-a0[i])); g1[i] = __builtin_amdgcn_rcpf(1.0f + __expf(-a1[i])); }
                    f32x4 r0, r1;
                    r0[0] = x0[0] + g0[0] * bflo(pw.x); r0[1] = x0[1] + g0[1] * bfhi(pw.x); r0[2] = x0[2] + g0[2] * bflo(pw.y); r0[3] = x0[3] + g0[3] * bfhi(pw.y);
                    r1[0] = x1[0] + g1[0] * bflo(pw.z); r1[1] = x1[1] + g1[1] * bfhi(pw.z); r1[2] = x1[2] + g1[2] * bflo(pw.w); r1[3] = x1[3] + g1[3] * bfhi(pw.w);
                    *(f32x4*)op = r0; *(f32x4*)(op + 4) = r1; } }
    }
};

template <class Epi, class Sched, bool ALIGN_EPI = false, bool SP2 = false>
__device__ __forceinline__ void gemm_phase(PG8_LAS unsigned char* lds, const Gemm g, const Sched& S, const Epi& E) {
    int tid_ = threadIdx.x; asm volatile("" : "+v"(tid_));
    const int tid = tid_, wid = __builtin_amdgcn_readfirstlane(tid >> 6), lane = tid & 63, wr = wid >> 2, wc = wid & 3, fr = lane & 15, fq = lane >> 4;
    const int K = g.K, nt = K / BK;
    unsigned voffA[2], voffB[2];
#pragma unroll
    for (int i = 0; i < 2; ++i) { int R, C; stage_rc(tid * 16 + i * 8192, R, C); const int Rb = Epi::PERM ? ((R & ~31) + perm32(R & 31)) : R;
        voffA[i] = (unsigned)(R * K + C) * 2u; voffB[i] = (unsigned)(Rb * K + C) * 2u; }
    const size_t kstep = (size_t)(BK * 2);
    const size_t hstep = (size_t)HALF * K * 2;
    const size_t tstep = 2 * hstep;
    const unsigned ldsw = (unsigned)wid * 1024u;
    const int aoff = lds_byte(wr * 64 + fr, fq * 8), boff = lds_byte(wc * 32 + fr, fq * 8);
#define PG8_SA(b, h) (((b) * 2 + (h)) * HTB)
#define PG8_SB(b, h) ((4 + (b) * 2 + (h)) * HTB)
#define PG8_STAGE(bufoff, gbase, voff) do { _Pragma("unroll") for (int _i = 0; _i < 2; ++_i) \
        __builtin_amdgcn_global_load_lds((const unsigned*)((const char*)(gbase) + (voff)[_i]), (PG8_LAS unsigned*)(lds + (bufoff) + ldsw + _i * 8192), 16, 0, 0); } while (0)
#define PG8_LDA(dst, b, h) do { _Pragma("unroll") for (int m = 0; m < 4; ++m) _Pragma("unroll") for (int k = 0; k < 2; ++k) dst[m][k] = *(const PG8_LAS bf16x8*)(lds + PG8_SA(b, h) + aoff + m * 2048 + k * 1024); } while (0)
#define PG8_LDB(dst, b, h) do { _Pragma("unroll") for (int n = 0; n < 2; ++n) _Pragma("unroll") for (int k = 0; k < 2; ++k) dst[n][k] = *(const PG8_LAS bf16x8*)(lds + PG8_SB(b, h) + boff + n * 2048 + k * 1024); } while (0)
#define PG8_MMA(ai, bj, At, Bt) do { __builtin_amdgcn_s_setprio(1); _Pragma("unroll") for (int m = 0; m < 4; ++m) _Pragma("unroll") for (int n = 0; n < 2; ++n) _Pragma("unroll") for (int k = 0; k < 2; ++k) \
        acc[ai][bj][m][n] = __builtin_amdgcn_mfma_f32_16x16x32_bf16(Bt[n][k], At[m][k], acc[ai][bj][m][n], 0, 0, 0); __builtin_amdgcn_s_setprio(0); } while (0)
#define PG8_WAIT_V(n) asm volatile("s_waitcnt vmcnt(" #n ")" ::: "memory")
#define PG8_WAIT_L(n) asm volatile("s_waitcnt lgkmcnt(" #n ")" ::: "memory")
#define PG8_BAR __builtin_amdgcn_s_barrier()
#define PG8_SCHED __builtin_amdgcn_sched_barrier(0)
    Unit cur, nxt; int ui = 0;
    if (!S.next(0, cur)) return;
    f32x4 acc[2][2][4][2];
#pragma unroll
    for (int a = 0; a < 2; ++a)
#pragma unroll
        for (int b = 0; b < 2; ++b)
#pragma unroll
            for (int m = 0; m < 4; ++m)
#pragma unroll
                for (int n = 0; n < 2; ++n) acc[a][b][m][n] = (f32x4){0.f, 0.f, 0.f, 0.f};
    bf16x8 At[4][2], B0[2][2], B1[2][2];
    const char* cA = (const char*)g.A + (size_t)cur.pm * tstep; const char* cB = (const char*)g.Bt + (size_t)S.btile(cur) * tstep;
    S.a_ready(cur);
    if constexpr (SP2) {
        PG8_STAGE(PG8_SB(0, 0), cB, voffB); PG8_STAGE(PG8_SB(0, 1), cB + hstep, voffB); PG8_STAGE(PG8_SA(0, 0), cA, voffA); PG8_STAGE(PG8_SA(0, 1), cA + hstep, voffA);
        if (wr == 1) PG8_BAR;
        PG8_WAIT_V(2); PG8_BAR;
        PG8_STAGE(PG8_SB(1, 0), cB + kstep, voffB); PG8_STAGE(PG8_SA(1, 0), cA + kstep, voffA); PG8_STAGE(PG8_SB(1, 1), cB + hstep + kstep, voffB);
        PG8_WAIT_V(6); PG8_BAR;
    } else {
        PG8_STAGE(PG8_SB(0, 0), cB, voffB); PG8_STAGE(PG8_SA(0, 0), cA, voffA); PG8_STAGE(PG8_SB(0, 1), cB + hstep, voffB); PG8_STAGE(PG8_SA(0, 1), cA + hstep, voffA);
        if (wr == 1) PG8_BAR;
        PG8_WAIT_V(4); PG8_BAR;
        PG8_STAGE(PG8_SB(1, 0), cB + kstep, voffB); PG8_STAGE(PG8_SA(1, 0), cA + kstep, voffA); PG8_STAGE(PG8_SB(1, 1), cB + hstep + kstep, voffB);
        PG8_WAIT_V(6); PG8_BAR;
    }
    for (;;) {
        const bool has_next = S.next(ui + 1, nxt);
        const char* nA = has_next ? (const char*)g.A + (size_t)nxt.pm * tstep : cA; const char* nB = has_next ? (const char*)g.Bt + (size_t)S.btile(nxt) * tstep : cB;
#pragma nounroll
        for (int t = 0; t < nt; t += 2) {
            const bool last = (t == nt - 2);
            const char* a1 = cA + (size_t)(t + 1) * kstep;
            const char* a2 = last ? nA : cA + (size_t)(t + 2) * kstep; const char* b2 = last ? nB : cB + (size_t)(t + 2) * kstep;
            const char* a3 = a2 + kstep; const char* b3 = b2 + kstep;
            if (last && has_next) S.a_ready(nxt);
            if constexpr (SP2) {
            PG8_LDB(B0, 0, 0); PG8_LDB(B1, 0, 1); PG8_SCHED; PG8_LDA(At, 0, 0); PG8_STAGE(PG8_SA(1, 1), a1 + hstep, voffA);
            PG8_WAIT_V(8); PG8_WAIT_L(0); PG8_BAR; PG8_MMA(0, 0, At, B0); PG8_MMA(0, 1, At, B1); PG8_BAR; PG8_SCHED;
            PG8_LDA(At, 0, 1); PG8_STAGE(PG8_SB(0, 0), b2, voffB); PG8_STAGE(PG8_SB(0, 1), b2 + hstep, voffB); PG8_STAGE(PG8_SA(0, 0), a2, voffA);
            PG8_WAIT_V(8); PG8_WAIT_L(0); PG8_BAR; PG8_MMA(1, 0, At, B0); PG8_MMA(1, 1, At, B1); PG8_BAR; PG8_SCHED;
            PG8_LDB(B0, 1, 0); PG8_LDB(B1, 1, 1); PG8_SCHED; PG8_LDA(At, 1, 0); PG8_STAGE(PG8_SA(0, 1), a2 + hstep, voffA);
            PG8_WAIT_V(8); PG8_WAIT_L(0); PG8_BAR; PG8_MMA(0, 0, At, B0); PG8_MMA(0, 1, At, B1); PG8_BAR; PG8_SCHED;
            PG8_LDA(At, 1, 1); PG8_STAGE(PG8_SB(1, 0), b3, voffB); PG8_STAGE(PG8_SB(1, 1), b3 + hstep, voffB); PG8_STAGE(PG8_SA(1, 0), a3, voffA);
            PG8_WAIT_V(8); PG8_WAIT_L(0); PG8_BAR; PG8_MMA(1, 0, At, B0); PG8_MMA(1, 1, At, B1); PG8_BAR; PG8_SCHED;
            } else {
            PG8_LDB(B0, 0, 0); PG8_SCHED; PG8_LDA(At, 0, 0); PG8_STAGE(PG8_SA(1, 1), a1 + hstep, voffA);
            PG8_WAIT_L(8); PG8_BAR; PG8_WAIT_L(0); PG8_MMA(0, 0, At, B0); PG8_BAR; PG8_SCHED;
            PG8_LDB(B1, 0, 1); PG8_STAGE(PG8_SB(0, 0), b2, voffB);
            PG8_BAR; PG8_WAIT_L(0); PG8_MMA(0, 1, At, B1); PG8_BAR;
            PG8_LDA(At, 0, 1); PG8_STAGE(PG8_SA(0, 0), a2, voffA);
            PG8_BAR; PG8_WAIT_L(0); PG8_MMA(1, 0, At, B0); PG8_BAR; PG8_SCHED;
            PG8_STAGE(PG8_SB(0, 1), b2 + hstep, voffB);
            PG8_WAIT_V(6); PG8_BAR; PG8_MMA(1, 1, At, B1); PG8_BAR;
            PG8_LDB(B0, 1, 0); PG8_SCHED; PG8_LDA(At, 1, 0); PG8_STAGE(PG8_SA(0, 1), a2 + hstep, voffA);
            PG8_WAIT_L(8); PG8_BAR; PG8_WAIT_L(0); PG8_MMA(0, 0, At, B0); PG8_BAR; PG8_SCHED;
            PG8_LDB(B1, 1, 1); PG8_STAGE(PG8_SB(1, 0), b3, voffB);
            PG8_BAR; PG8_WAIT_L(0); PG8_MMA(0, 1, At, B1); PG8_BAR;
            PG8_LDA(At, 1, 1); PG8_STAGE(PG8_SA(1, 0), a3, voffA);
            PG8_BAR; PG8_WAIT_L(0); PG8_MMA(1, 0, At, B0); PG8_BAR; PG8_SCHED;
            PG8_STAGE(PG8_SB(1, 1), b3 + hstep, voffB);
            PG8_WAIT_V(6); PG8_BAR; PG8_MMA(1, 1, At, B1); PG8_BAR;
            }
        }
        if constexpr (ALIGN_EPI) { if (wr == 0) PG8_BAR; }
        if constexpr (!Epi::AFTER_DRAIN) { E(acc, cur, wr, wc, fr, fq); S.done(cur); }
        if (!has_next) break;
#pragma unroll
        for (int a = 0; a < 2; ++a)
#pragma unroll
            for (int b = 0; b < 2; ++b)
#pragma unroll
                for (int m = 0; m < 4; ++m)
#pragma unroll
                    for (int n = 0; n < 2; ++n) acc[a][b][m][n] = (f32x4){0.f, 0.f, 0.f, 0.f};
        cur = nxt; cA = nA; cB = nB; ++ui;
        if constexpr (ALIGN_EPI) { if (wr == 1) PG8_BAR; }
    }
    PG8_WAIT_V(0);
    if constexpr (!ALIGN_EPI) { if (wr == 0) PG8_BAR; }
    PG8_BAR;
    if constexpr (Epi::AFTER_DRAIN) { E.fused(acc, cur, wr, wc, fr, fq, lds, wid, lane); S.done(cur); }
#undef PG8_SA
#undef PG8_SB
#undef PG8_STAGE
#undef PG8_LDA
#undef PG8_LDB
#undef PG8_MMA
#undef PG8_WAIT_V
#undef PG8_WAIT_L
#undef PG8_BAR
#undef PG8_SCHED
}
}

#define LAS __attribute__((address_space(3)))
#define GAS __attribute__((address_space(1)))
#define XB_TMO      128
#define XB_XCNT(j)  (256  + 64 * (j))
#define XB_XSUB(j)  (1280 + 64 * (j))
#define XB_XGEN(j)  (2304 + 64 * (j))
#define XB_TOP      3328
#define XB_TOPGEN   3392
#define XCD_BAR_WORDS 3456
#define XB_SPIN_CAP (1u << 18)

__device__ __forceinline__ unsigned xb_ld(unsigned* p)              { return __hip_atomic_load(p, __ATOMIC_RELAXED, __HIP_MEMORY_SCOPE_AGENT); }
__device__ __forceinline__ unsigned xb_add(unsigned* p, unsigned v) { return __hip_atomic_fetch_add(p, v, __ATOMIC_RELAXED, __HIP_MEMORY_SCOPE_AGENT); }
__device__ __forceinline__ unsigned xb_xcc_id() { return (unsigned)__builtin_amdgcn_s_getreg((3 << 11) | 20) & 0xFu; }
#define XB_SPIN(cond, bar) do { unsigned _sp = 0; while (cond) { __builtin_amdgcn_s_sleep(1); \
    if ((++_sp & 255u) == 0u) { if (xb_ld(&(bar)[XB_TMO])) break; if (_sp > XB_SPIN_CAP) { atomicAdd(&(bar)[XB_TMO], 1u); break; } } } } while (0)

struct XcdBarrier {
    unsigned* bar; unsigned x;
    volatile LAS unsigned* st;
};

__device__ __forceinline__ XcdBarrier xcd_barrier_post(unsigned* bar, volatile LAS unsigned* st) {
    XcdBarrier b; b.bar = bar; b.x = xb_xcc_id(); b.st = st;
    if (threadIdx.x == 0) (void)xb_add(&bar[XB_XCNT(b.x)], 1u);
    return b;
}
__device__ __forceinline__ void xcd_barrier_complete(unsigned* bar, unsigned x, unsigned& nloc, unsigned& nx) {
    const unsigned G = gridDim.x * gridDim.y * gridDim.z;
    unsigned sum, cnt, mine, sp = 0u;
    for (;;) {
        sum = 0u; cnt = 0u; mine = 0u;
#pragma unroll
        for (unsigned j = 0; j < 16; ++j) { const unsigned c = xb_ld(&bar[XB_XCNT(j)]); sum += c; cnt += (c > 0u) ? 1u : 0u; mine = (j == x) ? c : mine; }
        if (sum == G) break;
        __builtin_amdgcn_s_sleep(1);
        if ((++sp & 255u) == 0u) { if (xb_ld(&bar[XB_TMO])) break; if (sp > XB_SPIN_CAP) { atomicAdd(&bar[XB_TMO], 1u); break; } }
    }
    nloc = mine > 0u ? mine : 1u; nx = cnt > 0u ? cnt : 1u;
}

__device__ __forceinline__ void xcd_barrier(const XcdBarrier& b) {
    asm volatile("s_waitcnt vmcnt(0)" ::: "memory");
    __syncthreads();
    if (threadIdx.x == 0) {
        unsigned* bar = b.bar;
        __builtin_amdgcn_s_waitcnt(0);
        unsigned nloc = b.st[0], nx = b.st[1];
        if (nloc == 0u) { xcd_barrier_complete(bar, b.x, nloc, nx); b.st[0] = nloc; b.st[1] = nx; }
        const unsigned old = xb_add(&bar[XB_XSUB(b.x)], 1u);
        const unsigned gen = old / nloc;
        if (old + 1u == (gen + 1u) * nloc) {
            __builtin_amdgcn_fence(__ATOMIC_RELEASE, "agent");
            asm volatile("s_waitcnt vmcnt(0)" ::: "memory");
            const unsigned og = xb_add(&bar[XB_TOP], 1u);
            const unsigned tg = og / nx;
            if (og + 1u == (tg + 1u) * nx) xb_add(&bar[XB_TOPGEN], 1u);
            else XB_SPIN(xb_ld(&bar[XB_TOPGEN]) == tg, bar);
            __builtin_amdgcn_fence(__ATOMIC_ACQUIRE, "agent");
            xb_add(&bar[XB_XGEN(b.x)], 1u);
            asm volatile("s_waitcnt vmcnt(0)" ::: "memory");
        } else {
            XB_SPIN(xb_ld(&bar[XB_XGEN(b.x)]) == gen, bar);
            __builtin_amdgcn_fence(__ATOMIC_ACQUIRE, "agent");
            asm volatile("s_waitcnt vmcnt(0)" ::: "memory");
        }
    }
    __syncthreads();
}

typedef unsigned short bf16;
typedef unsigned v4u __attribute__((ext_vector_type(4)));
typedef unsigned v2u __attribute__((ext_vector_type(2)));
typedef float f32x4 __attribute__((ext_vector_type(4)));
typedef float f32x2_t __attribute__((ext_vector_type(2)));
typedef __bf16 bf16x2_t __attribute__((ext_vector_type(2)));
typedef short bf16x8 __attribute__((ext_vector_type(8)));
typedef short s16x4 __attribute__((ext_vector_type(4)));
typedef float f32x16 __attribute__((ext_vector_type(16)));
#define LDS_WAIT() asm volatile("s_waitcnt lgkmcnt(0)" ::: "memory")
#define VM_WAIT() asm volatile("s_waitcnt vmcnt(0)" ::: "memory")
#define SBAR() __builtin_amdgcn_sched_barrier(0)
__device__ __forceinline__ unsigned pk2(float lo, float hi) { f32x2_t v = {lo, hi}; bf16x2_t b = __builtin_convertvector(v, bf16x2_t); return __builtin_bit_cast(unsigned, b); }
__device__ __forceinline__ float bf2f(unsigned short h) { return __builtin_bit_cast(float, (unsigned)h << 16); }
__device__ __forceinline__ float wave_sum(float v) {
#pragma unroll
    for (int o = 1; o < 64; o <<= 1) v += __shfl_xor(v, o);
    return v;
}
__device__ const float INV_FREQ[16] = {1.000000000e+00f, 5.623413324e-01f, 3.162277639e-01f, 1.778279394e-01f, 1.000000015e-01f, 5.623412877e-02f, 3.162277862e-02f, 1.778279431e-02f,
                                       9.999999776e-03f, 5.623413250e-03f, 3.162277862e-03f, 1.778279431e-03f, 1.000000047e-03f, 5.623413017e-04f, 3.162277862e-04f, 1.778279402e-04f};

constexpr size_t MiB = 1u << 20, KiB = 1u << 10;
constexpr size_t WS_CTL = 0, CTL_ZERO_BYTES = 64 * KiB;
constexpr size_t WS_WIN = 1 * MiB;
constexpr size_t WS_WUQ = WS_WIN + (size_t)IN_PAD * DM * 2;
constexpr size_t WS_WUKV = WS_WUQ + 768 * 256 * 2;
constexpr size_t WS_WOUT = WS_WUKV + 1024 * 256 * 2;
constexpr size_t WS_WPG = WS_WOUT + 2 * MiB;
constexpr size_t WS_WPP = WS_WPG + 2 * MiB;
constexpr size_t WS_WGU = 9 * MiB;
constexpr size_t WS_WD = WS_WGU + 32 * MiB;
constexpr size_t WS_COS = WS_WD + 16 * MiB, WS_SIN = WS_COS + 1 * MiB;
constexpr size_t WS_AFF = WS_SIN + 1 * MiB;
constexpr size_t WS_INV = WS_AFF + 1 * MiB;
constexpr size_t WS_SEL = WS_INV + 1 * MiB;
constexpr size_t WS_VAL = WS_SEL + 128 * KiB;
constexpr size_t WS_HB = 62 * MiB;
constexpr size_t WS_Y = 94 * MiB;
constexpr size_t WS_R1 = 126 * MiB;
constexpr size_t WS_QA = WS_R1;
constexpr size_t WS_KVA = WS_QA + 16 * MiB;
constexpr size_t WS_ZB = WS_KVA + 8 * MiB;
constexpr size_t WS_CQN = WS_ZB + 26 * MiB;
constexpr size_t WS_CKVN = WS_CQN + 8 * MiB;
constexpr size_t WS_KR = WS_CKVN + 8 * MiB;
constexpr size_t WS_QB = WS_KR + 1 * MiB;
constexpr size_t WS_KVB = WS_QB + 24 * MiB;
constexpr size_t WS_XG = WS_R1;
constexpr size_t WS_ACT = WS_R1 + 64 * MiB;
constexpr size_t WS_OB = WS_R1;
constexpr size_t WS_PROJ = WS_R1 + 64 * MiB;
constexpr size_t WS_PB = WS_R1 + 96 * MiB;
constexpr size_t WS_END = 254 * MiB;
static_assert(WS_WPP + 1024 * 256 * 2 <= WS_WGU && WS_VAL + 128 * KiB <= WS_HB && WS_KVB + 32 * MiB <= WS_END && WS_PB + 8 * MiB <= WS_END, "d_ws map");
constexpr int CW_BAR = 1024;
static_assert((CW_BAR + XCD_BAR_WORDS) * 4 <= (int)CTL_ZERO_BYTES, "CTL words inside the memset region");

constexpr int RING_BYTES = 131072;
constexpr int MISC_OFF = RING_BYTES;
constexpr int LDS_BYTES = 147456;
constexpr int NWAVES = 8;

namespace att {
#define KSWZ(row, colB) ((row) * 256 + ((colB) ^ (((row) & 7) << 4)))
__device__ __forceinline__ int crow(int r, int hi) { return (r & 3) + 8 * (r >> 2) + 4 * hi; }
__device__ __forceinline__ unsigned cvtpk(float lo, float hi) { return pk2(lo, hi); }
__device__ __forceinline__ int v_st(int k, int c) { const int kk = (k & ~0xC) | ((k & 4) << 1) | ((k & 8) >> 1); return ((kk >> 3) * 2 + (c >> 5)) * 512 + ((kk & 7) * 32 + (c & 31)) * 2; }
__device__ __forceinline__ int v_rd_base(int lane) { return ((lane & 3) << 3) | (((lane >> 2) & 3) << 6) | (((lane >> 4) & 1) << 5) | (((lane >> 5) & 1) << 8); }
constexpr int v_rd_off(int d0, int ks, int half) { return d0 * 512 + ks * 2048 + half * 1024; }
template <int OFF> __device__ __forceinline__ s16x4 tr_read(int vb) {
  s16x4 r; asm volatile("ds_read_b64_tr_b16 %0, %1 offset:%2" : "=&v"(r) : "v"(vb), "i"(OFF) : "memory"); return r;
}
template <int D0> __device__ __forceinline__ void pv_one(f32x16& od, int vb, bf16x8 pa0, bf16x8 pa1, bf16x8 pa2, bf16x8 pa3) {
  const s16x4 l0 = tr_read<v_rd_off(D0, 0, 0)>(vb), h0 = tr_read<v_rd_off(D0, 0, 1)>(vb), l1 = tr_read<v_rd_off(D0, 1, 0)>(vb), h1 = tr_read<v_rd_off(D0, 1, 1)>(vb);
  const s16x4 l2 = tr_read<v_rd_off(D0, 2, 0)>(vb), h2 = tr_read<v_rd_off(D0, 2, 1)>(vb), l3 = tr_read<v_rd_off(D0, 3, 0)>(vb), h3 = tr_read<v_rd_off(D0, 3, 1)>(vb);
  asm volatile("s_waitcnt lgkmcnt(0)" ::: "memory"); SBAR();
#define PK(L, H) (bf16x8){L[0], L[1], L[2], L[3], H[0], H[1], H[2], H[3]}
  od = __builtin_amdgcn_mfma_f32_32x32x16_bf16(pa0, PK(l0, h0), od, 0, 0, 0);
  od = __builtin_amdgcn_mfma_f32_32x32x16_bf16(pa1, PK(l1, h1), od, 0, 0, 0);
  od = __builtin_amdgcn_mfma_f32_32x32x16_bf16(pa2, PK(l2, h2), od, 0, 0, 0);
  od = __builtin_amdgcn_mfma_f32_32x32x16_bf16(pa3, PK(l3, h3), od, 0, 0, 0);
#undef PK
}
__device__ __forceinline__ void pv_2(f32x16* o, int vb, bf16x8 pa0, bf16x8 pa1, bf16x8 pa2, bf16x8 pa3) {
  pv_one<0>(o[0], vb, pa0, pa1, pa2, pa3); pv_one<1>(o[1], vb, pa0, pa1, pa2, pa3);
}
__device__ __forceinline__ void pack_p(const f32x16& p0, const f32x16& p1, bf16x8& pa0, bf16x8& pa1, bf16x8& pa2, bf16x8& pa3) {
#define PK4(P, BASE, OUT) do { unsigned a0 = cvtpk(P[BASE + 0], P[BASE + 1]), a1 = cvtpk(P[BASE + 2], P[BASE + 3]);   \
    unsigned b0 = cvtpk(P[BASE + 4], P[BASE + 5]), b1 = cvtpk(P[BASE + 6], P[BASE + 7]);                              \
    auto r0 = __builtin_amdgcn_permlane32_swap(a0, b0, false, false); auto r1 = __builtin_amdgcn_permlane32_swap(a1, b1, false, false); \
    v4u w = {r0[0], r1[0], r0[1], r1[1]}; OUT = __builtin_bit_cast(bf16x8, w); } while (0)
  PK4(p0, 0, pa0); PK4(p0, 8, pa1); PK4(p1, 0, pa2); PK4(p1, 8, pa3);
#undef PK4
}

namespace mla {
constexpr int NW = 8, QBLK = 32, KVBLK = 64;
constexpr float SCALE = 0.10206207261596575f;
constexpr float THR = 8.f;
constexpr int SHM_V = 8192, SHM_K = 16384, SHM_TOTAL = 2 * SHM_V + 2 * SHM_K + NW * 64 * 4;
__device__ __forceinline__ void partialSM(f32x16& p0, f32x16& p1, float& m_reg, float& mn, float& alpha) {
  constexpr float C = SCALE * LOG2E;
  float pmax = p0[0];
#pragma unroll
  for (int r = 1; r < 16; ++r) pmax = fmaxf(pmax, p0[r]);
#pragma unroll
  for (int r = 0; r < 16; ++r) pmax = fmaxf(pmax, p1[r]);
  { auto rr = __builtin_amdgcn_permlane32_swap(__float_as_uint(pmax), __float_as_uint(pmax), false, false);
    pmax = fmaxf(__uint_as_float(rr[0]), __uint_as_float(rr[1])); }
  if (__builtin_expect(__all(pmax - m_reg <= THR / SCALE), 1)) { mn = m_reg; alpha = 1.f; }
  else { mn = fmaxf(m_reg, pmax); alpha = __builtin_amdgcn_exp2f((m_reg - mn) * C); m_reg = mn; }
  const float mnC = -mn * C;
#pragma unroll
  for (int r = 0; r < 16; ++r) p0[r] = fmaf(p0[r], C, mnC);
#pragma unroll
  for (int r = 0; r < 16; ++r) p1[r] = fmaf(p1[r], C, mnC);
#pragma unroll
  for (int r = 0; r < 16; ++r) p0[r] = __builtin_amdgcn_exp2f(p0[r]);
}
__device__ __forceinline__ void finishSM(f32x16& p0, f32x16& p1, float alpha, float& l_reg, bf16x8& pa0, bf16x8& pa1, bf16x8& pa2, bf16x8& pa3) {
#pragma unroll
  for (int r = 0; r < 16; ++r) p1[r] = __builtin_amdgcn_exp2f(p1[r]);
  float ps = 0;
#pragma unroll
  for (int r = 0; r < 16; ++r) ps += p0[r];
#pragma unroll
  for (int r = 0; r < 16; ++r) ps += p1[r];
  { auto rr = __builtin_amdgcn_permlane32_swap(__float_as_uint(ps), __float_as_uint(ps), false, false);
    ps = __uint_as_float(rr[0]) + __uint_as_float(rr[1]); }
  l_reg = l_reg * alpha + ps;
  pack_p(p0, p1, pa0, pa1, pa2, pa3);
}
__device__ __forceinline__ void qkt(f32x16& p0, f32x16& p1, const char* Ks, const bf16x8* qr, int r32, int hi) {
  p0 = f32x16{}; p1 = f32x16{};
#pragma unroll
  for (int d0 = 0; d0 < 6; ++d0) { const int cb = (d0 * 16 + hi * 8) * 2;
    const bf16x8 b0 = *reinterpret_cast<const bf16x8*>(Ks + KSWZ(r32, cb));
    const bf16x8 b1 = *reinterpret_cast<const bf16x8*>(Ks + KSWZ(32 + r32, cb));
    p0 = __builtin_amdgcn_mfma_f32_32x32x16_bf16(b0, qr[d0], p0, 0, 0, 0);
    p1 = __builtin_amdgcn_mfma_f32_32x32x16_bf16(b1, qr[d0], p1, 0, 0, 0); }
}
__device__ __forceinline__ void unit(int b, int h, int qb, const bf16* __restrict__ QB, const bf16* __restrict__ KVB, const bf16* __restrict__ KR,
                                     const float* __restrict__ COS, const float* __restrict__ SIN, bf16* __restrict__ Y, char* lds) {
  int tid_ = threadIdx.x; asm volatile("" : "+v"(tid_));
  const int tid = tid_, wid = tid >> 6, lane = tid & 63, r32 = lane & 31, hi = lane >> 5;
  char* V_lds = lds; char* K_lds = lds + 2 * SHM_V;
  float* ws = (float*)(lds + 2 * SHM_V + 2 * SHM_K) + wid * 64; float* li_l = ws; float* al_l = ws + 32;
  float m_reg = -1e30f, l_reg = 0; f32x16 o[2] = {}; bf16x8 qr[6];
  const size_t tokq = (size_t)b * SEQ + qb * 256 + wid * QBLK + r32;
  { const bf16* Qw = QB + tokq * 768 + h * 96 + hi * 8;
#pragma unroll
    for (int d0 = 0; d0 < 6; ++d0) qr[d0] = *reinterpret_cast<const bf16x8*>(Qw + d0 * 16);
    const f32x4 c0 = *(const f32x4*)(COS + tokq * 16 + hi * 8), c1 = *(const f32x4*)(COS + tokq * 16 + hi * 8 + 4);
    const f32x4 s0 = *(const f32x4*)(SIN + tokq * 16 + hi * 8), s1 = *(const f32x4*)(SIN + tokq * 16 + hi * 8 + 4);
    float o1[8], o2[8];
#pragma unroll
    for (int j = 0; j < 8; ++j) { const float t1 = bf2f((unsigned short)qr[4][j]), t2 = bf2f((unsigned short)qr[5][j]); const float c = j < 4 ? c0[j & 3] : c1[j & 3], s = j < 4 ? s0[j & 3] : s1[j & 3];
      o1[j] = t1 * c - t2 * s; o2[j] = t1 * s + t2 * c; }
    v4u w1 = {pk2(o1[0], o1[1]), pk2(o1[2], o1[3]), pk2(o1[4], o1[5]), pk2(o1[6], o1[7])}, w2 = {pk2(o2[0], o2[1]), pk2(o2[2], o2[3]), pk2(o2[4], o2[5]), pk2(o2[6], o2[7])};
    qr[4] = __builtin_bit_cast(bf16x8, w1); qr[5] = __builtin_bit_cast(bf16x8, w2); }
  const int ksr = tid >> 4, kcc = tid & 15, kc = kcc < 12 ? kcc : kcc - 4;
  const bf16* kbase = kc < 8 ? KVB + ((size_t)b * SEQ + ksr) * 1024 + h * 128 + kc * 8 : KR + ((size_t)b * SEQ + ksr) * 32 + (kc - 8) * 8;
  const int kstr = kc < 8 ? 1024 : 32;
  const int vrow = tid >> 3, vcc = tid & 7;
  const bf16* vbase = KVB + ((size_t)b * SEQ + vrow) * 1024 + h * 128 + 64 + vcc * 8;
  const int kst0 = KSWZ(ksr, kc * 16), kst1 = KSWZ(32 + ksr, kc * 16), vst = v_st(vrow, vcc * 8);
  const int vb0 = (int)(uintptr_t)V_lds + v_rd_base(lane);
  struct { bf16x8 vs, ks0, ks1; } sr_[2];
#define SLOAD(i, k0) do { sr_[i].vs = *reinterpret_cast<const bf16x8*>(vbase + (size_t)(k0) * 1024); \
    sr_[i].ks0 = *reinterpret_cast<const bf16x8*>(kbase + (size_t)(k0) * kstr); sr_[i].ks1 = *reinterpret_cast<const bf16x8*>(kbase + (size_t)((k0) + 32) * kstr); } while (0)
#define SWRITE(bb, i) do { *(bf16x8*)(V_lds + (bb) * SHM_V + vst) = sr_[i].vs; *(bf16x8*)(K_lds + (bb) * SHM_K + kst0) = sr_[i].ks0; *(bf16x8*)(K_lds + (bb) * SHM_K + kst1) = sr_[i].ks1; } while (0)
#define SWAIT() asm volatile("s_waitcnt vmcnt(3)" ::: "memory")
#define RESC(a) do { if (__any((a) < 1.f)) { if (hi == 0) al_l[r32] = (a); asm volatile("s_waitcnt lgkmcnt(0)" ::: "memory"); \
    _Pragma("unroll") for (int d = 0; d < 2; ++d) _Pragma("unroll") for (int r = 0; r < 16; ++r) o[d][r] *= al_l[crow(r, hi)]; } } while (0)
  f32x16 pA0, pA1, pB0, pB1; float mnA, mnB, alA, alB; bf16x8 pa0, pa1, pa2, pa3; constexpr int NT = SEQ / KVBLK;
  constexpr int SE = 0, SO = 1;
  SLOAD(SE, 0); asm volatile("s_waitcnt vmcnt(0)" ::: "memory"); SWRITE(0, SE); __syncthreads();
  qkt(pA0, pA1, K_lds, qr, r32, hi); partialSM(pA0, pA1, m_reg, mnA, alA);
  SLOAD(SO, KVBLK); SLOAD(SE, 2 * KVBLK);
  SWAIT(); SWRITE(1, SO); __syncthreads();
  for (int j = 1; j + 1 < NT; j += 2) {
    SBAR(); qkt(pB0, pB1, K_lds + SHM_K, qr, r32, hi);
    finishSM(pA0, pA1, alA, l_reg, pa0, pa1, pa2, pa3); SBAR();
    SLOAD(SO, (j + 2) * KVBLK); SBAR();
    pv_2(o, vb0, pa0, pa1, pa2, pa3); partialSM(pB0, pB1, m_reg, mnB, alB);
    __syncthreads(); SWAIT(); SWRITE(0, SE);
    RESC(alB); __syncthreads();
    SBAR(); qkt(pA0, pA1, K_lds, qr, r32, hi);
    finishSM(pB0, pB1, alB, l_reg, pa0, pa1, pa2, pa3); SBAR();
    if (j + 3 < NT) SLOAD(SE, (j + 3) * KVBLK); SBAR();
    pv_2(o, vb0 + SHM_V, pa0, pa1, pa2, pa3); partialSM(pA0, pA1, m_reg, mnA, alA);
    __syncthreads(); SWAIT(); SWRITE(1, SO);
    RESC(alA); __syncthreads();
  }
  SBAR(); qkt(pB0, pB1, K_lds + SHM_K, qr, r32, hi);
  finishSM(pA0, pA1, alA, l_reg, pa0, pa1, pa2, pa3); SBAR();
  pv_2(o, vb0, pa0, pa1, pa2, pa3); partialSM(pB0, pB1, m_reg, mnB, alB);
  __syncthreads(); RESC(alB);
  finishSM(pB0, pB1, alB, l_reg, pa0, pa1, pa2, pa3); SBAR();
  pv_2(o, vb0 + SHM_V, pa0, pa1, pa2, pa3);
  if (hi == 0) li_l[r32] = l_reg; asm volatile("s_waitcnt lgkmcnt(0)" ::: "memory");
  float rli[16];
#pragma unroll
  for (int r = 0; r < 16; ++r) rli[r] = __builtin_amdgcn_rcpf(li_l[crow(r, hi)]);
  bf16* Ow = Y + ((size_t)b * SEQ + qb * 256 + wid * QBLK) * 1024 + 512 + h * 64;
#pragma unroll
  for (int r = 0; r < 16; ++r) { const int orow = crow(r, hi);
#pragma unroll
    for (int d0 = 0; d0 < 2; ++d0) Ow[(size_t)orow * 1024 + d0 * 32 + r32] = (bf16)(pk2(o[d0][r] * rli[r], 0.f) & 0xffffu); }
  __syncthreads();
#undef SLOAD
#undef SWRITE
#undef SWAIT
#undef RESC
}
}

namespace wnd {
constexpr int LDS_V = 0, LDS_K = 8192, LDS_TAB = 8192 + 16384, LDS_WS = LDS_TAB + 2048, LDS_TOTAL = LDS_WS + 8 * 256;
__device__ __forceinline__ int t5_bucket(int rel) {
  const int n = rel < 0 ? -rel : rel; int bk;
  if (n < 8) bk = n; else bk = 8 + (n > 11) + (n > 15) + (n > 22) + (n > 31) + (n > 45) + (n > 63) + (n > 90);
  return (rel > 0 ? 16 : 0) + bk;
}
__device__ __forceinline__ void unit(int b, int h, int qb, const bf16* __restrict__ QA, const bf16* __restrict__ KVA, const float* __restrict__ rel_bias, const float* __restrict__ sink,
                                     bf16* __restrict__ Y, char* lds) {
  int tid_ = threadIdx.x; asm volatile("" : "+v"(tid_));
  const int tid = tid_, wid = tid >> 6, lane = tid & 63, r32 = lane & 31, hi = lane >> 5, kvh = h >> 2;
  char* V_lds = lds + LDS_V; char* K_lds = lds + LDS_K; float* tab = (float*)(lds + LDS_TAB); float* al_l = (float*)(lds + LDS_WS) + wid * 64; float* li_l = al_l + 32;
  for (int i = tid; i < 385; i += 512) { const int rel = i - 192, n = rel < 0 ? -rel : rel; tab[i] = n <= 128 ? rel_bias[t5_bucket(rel) * 8 + h] * LOG2E : -1e30f; }
  const int q0 = qb * 256;
  bf16x8 qr[4];
  { const bf16* Qw = QA + ((size_t)b * SEQ + q0 + wid * 32 + r32) * 512 + h * 64 + hi * 8;
#pragma unroll
    for (int d0 = 0; d0 < 4; ++d0) qr[d0] = *reinterpret_cast<const bf16x8*>(Qw + d0 * 16); }
  float m_reg = sink[h] * LOG2E, l_reg = 1.0f; f32x16 o[2] = {};
  const int srow = tid >> 3, scc = tid & 7;
  const bf16* kbase = KVA + (size_t)b * SEQ * 256 + kvh * 64 + scc * 8; const bf16* vbase = kbase + 128;
  const int kst = KSWZ(srow, scc * 16), vst = v_st(srow, scc * 8);
  const int vb0 = (int)(uintptr_t)V_lds + v_rd_base(lane);
  constexpr float C = 0.125f * LOG2E;
  const int t_lo = qb == 0 ? 2 : 0, t_hi = qb == SEQ / 256 - 1 ? 6 : 8, wlo = wid >> 1;
  for (int t = t_lo; t < t_hi; ++t) {
    const int k0 = q0 - 128 + 64 * t;
    const bf16x8 kreg = *reinterpret_cast<const bf16x8*>(kbase + (size_t)(k0 + srow) * 256), vreg = *reinterpret_cast<const bf16x8*>(vbase + (size_t)(k0 + srow) * 256);
    __syncthreads();
    *(bf16x8*)(K_lds + kst) = kreg; *(bf16x8*)(V_lds + vst) = vreg;
    __syncthreads();
    if (t >= wlo && t <= wlo + 4) {
      f32x16 p0 = {}, p1 = {};
#pragma unroll
      for (int d0 = 0; d0 < 4; ++d0) { const int cb = (d0 * 16 + hi * 8) * 2;
        const bf16x8 b0 = *reinterpret_cast<const bf16x8*>(K_lds + KSWZ(r32, cb)), b1 = *reinterpret_cast<const bf16x8*>(K_lds + KSWZ(32 + r32, cb));
        p0 = __builtin_amdgcn_mfma_f32_32x32x16_bf16(b0, qr[d0], p0, 0, 0, 0); p1 = __builtin_amdgcn_mfma_f32_32x32x16_bf16(b1, qr[d0], p1, 0, 0, 0); }
      const int base = k0 - (q0 + wid * 32 + r32) + 192 + 4 * hi;
#pragma unroll
      for (int r = 0; r < 16; ++r) { const int i0 = base + (r & 3) + 8 * (r >> 2); p0[r] = fmaf(p0[r], C, tab[i0]); p1[r] = fmaf(p1[r], C, tab[i0 + 32]); }
      float pmax = p0[0];
#pragma unroll
      for (int r = 1; r < 16; ++r) pmax = fmaxf(pmax, p0[r]);
#pragma unroll
      for (int r = 0; r < 16; ++r) pmax = fmaxf(pmax, p1[r]);
      { auto rr = __builtin_amdgcn_permlane32_swap(__float_as_uint(pmax), __float_as_uint(pmax), false, false); pmax = fmaxf(__uint_as_float(rr[0]), __uint_as_float(rr[1])); }
      const float mn = fmaxf(m_reg, pmax), alpha = __builtin_amdgcn_exp2f(m_reg - mn); m_reg = mn;
      float ps = 0.f;
#pragma unroll
      for (int r = 0; r < 16; ++r) { p0[r] = __builtin_amdgcn_exp2f(p0[r] - mn); p1[r] = __builtin_amdgcn_exp2f(p1[r] - mn); ps += p0[r] + p1[r]; }
      { auto rr = __builtin_amdgcn_permlane32_swap(__float_as_uint(ps), __float_as_uint(ps), false, false); ps = __uint_as_float(rr[0]) + __uint_as_float(rr[1]); }
      l_reg = l_reg * alpha + ps;
      if (__any(alpha < 1.f)) { if (hi == 0) al_l[r32] = alpha; asm volatile("s_waitcnt lgkmcnt(0)" ::: "memory");
#pragma unroll
        for (int d = 0; d < 2; ++d)
#pragma unroll
          for (int r = 0; r < 16; ++r) o[d][r] *= al_l[crow(r, hi)]; }
      bf16x8 pa0, pa1, pa2, pa3; pack_p(p0, p1, pa0, pa1, pa2, pa3);
      SBAR(); pv_2(o, vb0, pa0, pa1, pa2, pa3);
    }
  }
  if (hi == 0) li_l[r32] = l_reg; asm volatile("s_waitcnt lgkmcnt(0)" ::: "memory");
  float rli[16];
#pragma unroll
  for (int r = 0; r < 16; ++r) rli[r] = __builtin_amdgcn_rcpf(li_l[crow(r, hi)]);
  bf16* Ow = Y + ((size_t)b * SEQ + q0 + wid * 32) * 1024 + h * 64;
#pragma unroll
  for (int r = 0; r < 16; ++r) { const int orow = crow(r, hi);
#pragma unroll
    for (int d0 = 0; d0 < 2; ++d0) Ow[(size_t)orow * 1024 + d0 * 32 + r32] = (bf16)(pk2(o[d0][r] * rli[r], 0.f) & 0xffffu); }
  __syncthreads();
}
}
#undef KSWZ
}

struct Args { const void* in[23]; float* out; unsigned char* ws; };
typedef const __attribute__((address_space(4))) Args* KArgs;
__device__ __forceinline__ KArgs kargs() { KArgs p = (KArgs)__builtin_amdgcn_kernarg_segment_ptr(); asm volatile("" : "+s"(p)); return p; }
struct Frame {
    char* lds; int tid, lane, wave, vcu, G, gw, NGW;
    unsigned char* ws;
};

__device__ __forceinline__ void transpose_item(const float* __restrict__ W, int N, int k0, int n0, bf16* dst  , int ldk, float* scr, int lane) {
#pragma unroll 8
    for (int i = 0; i < 32; ++i) { const int kk = 2 * i + (lane >> 5); scr[kk * 33 + (lane & 31)] = W[(size_t)(k0 + kk) * N + n0 + (lane & 31)]; }
    LDS_WAIT(); asm volatile("" ::: "memory");
    const int c = lane & 7;
#pragma unroll
    for (int j = 0; j < 4; ++j) { const int n = (lane >> 3) + 8 * j; const float* s = scr + (8 * c) * 33 + n;
        v4u o; o.x = pk2(s[0 * 33], s[1 * 33]); o.y = pk2(s[2 * 33], s[3 * 33]); o.z = pk2(s[4 * 33], s[5 * 33]); o.w = pk2(s[6 * 33], s[7 * 33]);
        *(v4u*)(dst + (size_t)n * ldk + k0 + 8 * c) = o; }
    LDS_WAIT(); asm volatile("" ::: "memory");
}

__device__ __forceinline__ void p0_prologue(const Frame& F) {
    const KArgs ka = kargs();
    float* scr = (float*)(F.lds + F.wave * 16384);
    unsigned char* ws = F.ws;
    const float* w_in = (const float*)ka->in[5]; const float* w_uq = (const float*)ka->in[9]; const float* w_ukv = (const float*)ka->in[10]; const float* w_out = (const float*)ka->in[13];
    const float* w_eg = (const float*)ka->in[16]; const float* w_eu = (const float*)ka->in[17]; const float* w_ed = (const float*)ka->in[18]; const float* w_pg = (const float*)ka->in[20]; const float* w_pp = (const float*)ka->in[21];
    constexpr int I_IN = 16 * 37, I_UQ = 4 * 24, I_UKV = 2 * 32, I_OUT = 16 * 32, I_G = 16 * 16 * 16, I_D = 16 * 8 * 32, I_PG = 16 * 32, I_PP = 4 * 32;
    constexpr int NITEMS = I_IN + I_UQ + I_UKV + I_OUT + 2 * I_G + I_D + I_PG + I_PP;
    for (int it = F.gw; it < NITEMS; it += F.NGW) {
        int r = it;
        if (r < I_IN) { const int kb = r / 37, nb = r % 37; transpose_item(w_in, IN_COLS, 64 * kb, 32 * nb, (bf16*)(ws + WS_WIN) + (size_t)(32 * nb) * 1024, 1024, scr, F.lane); continue; } r -= I_IN;
        if (r < I_UQ) { const int kb = r / 24, nb = r % 24; transpose_item(w_uq, 768, 64 * kb, 32 * nb, (bf16*)(ws + WS_WUQ) + (size_t)(32 * nb) * 256, 256, scr, F.lane); continue; } r -= I_UQ;
        if (r < I_UKV) { const int kb = r / 32, nb = r % 32; transpose_item(w_ukv, 1024, 64 * kb, 32 * nb, (bf16*)(ws + WS_WUKV) + (size_t)(32 * nb) * 256, 256, scr, F.lane); continue; } r -= I_UKV;
        if (r < I_OUT) { const int kb = r / 32, nb = r % 32; transpose_item(w_out, 1024, 64 * kb, 32 * nb, (bf16*)(ws + WS_WOUT) + (size_t)(32 * nb) * 1024, 1024, scr, F.lane); continue; } r -= I_OUT;
        if (r < 2 * I_G) { const int up = r >= I_G; if (up) r -= I_G; const int e = r / 256, q = r % 256, kb = q / 16, nb = q % 16, n0 = 32 * nb;
            const size_t drow = (size_t)e * 1024 + 256 * (n0 / 128) + (n0 % 128) + (up ? 128 : 0);
            transpose_item((up ? w_eu : w_eg) + (size_t)e * 1024 * 512, 512, 64 * kb, n0, (bf16*)(ws + WS_WGU) + drow * 1024, 1024, scr, F.lane); continue; } r -= 2 * I_G;
        if (r < I_D) { const int e = r / 256, q = r % 256, kb = q / 32, nb = q % 32;
            transpose_item(w_ed + (size_t)e * 512 * 1024, 1024, 64 * kb, 32 * nb, (bf16*)(ws + WS_WD) + ((size_t)e * 1024 + 32 * nb) * 512, 512, scr, F.lane); continue; } r -= I_D;
        if (r < I_PG) { const int kb = r / 32, nb = r % 32; transpose_item(w_pg, 1024, 64 * kb, 32 * nb, (bf16*)(ws + WS_WPG) + (size_t)(32 * nb) * 1024, 1024, scr, F.lane); continue; } r -= I_PG;
        { const int kb = r / 32, nb = r % 32; transpose_item(w_pp, 1024, 64 * kb, 32 * nb, (bf16*)(ws + WS_WPP) + (size_t)(32 * nb) * 256, 256, scr, F.lane); }
    }
    const int gt = F.vcu * 512 + F.tid, NGT = F.G * 512;
    for (int i = gt; i < 96 * 128; i += NGT) ((v4u*)((bf16*)(ws + WS_WIN) + (size_t)IN_COLS * 1024))[i] = (v4u){0u, 0u, 0u, 0u};
    for (int i = gt; i < 1024 * 16; i += NGT) *(v4u*)((bf16*)(ws + WS_WUKV) + (size_t)(i >> 4) * 256 + 128 + (i & 15) * 8) = (v4u){0u, 0u, 0u, 0u};
    const int* positions = (const int*)ka->in[2];
    for (int i = gt; i < T * 16; i += NGT) {
        const float ang = (float)positions[i >> 4] * INV_FREQ[i & 15];
        const double x = (double)ang, q = __builtin_rint(x * 0.63661977236758134308);
        const double r = (x - q * 1.5707963267948966192) - q * 6.123233995736766036e-17, r2 = r * r;
        const double sn = r * (1.0 + r2 * (-1.0 / 6 + r2 * (1.0 / 120 + r2 * (-1.0 / 5040 + r2 * (1.0 / 362880 + r2 * (-1.0 / 39916800 + r2 * (1.0 / 6227020800.0)))))));
        const double cs = 1.0 + r2 * (-0.5 + r2 * (1.0 / 24 + r2 * (-1.0 / 720 + r2 * (1.0 / 40320 + r2 * (-1.0 / 3628800 + r2 * (1.0 / 479001600.0 + r2 * (-1.0 / 87178291200.0)))))));
        const int qi = (int)((long long)q & 3);
        const double c_ = (qi == 0) ? cs : (qi == 1) ? -sn : (qi == 2) ? -cs : sn, s_ = (qi == 0) ? sn : (qi == 1) ? cs : (qi == 2) ? -sn : -cs;
        ((float*)(ws + WS_COS))[i] = (float)c_; ((float*)(ws + WS_SIN))[i] = (float)s_;
    }
    const float* x = (const float*)ka->in[0]; const float* g = (const float*)ka->in[4]; bf16* H = (bf16*)(ws + WS_HB);
    for (int m = F.gw; m < T; m += F.NGW) {
        const f32x4* xr = (const f32x4*)(x + (size_t)m * DM) + F.lane; f32x4 v[4]; float s = 0.f;
#pragma unroll
        for (int j = 0; j < 4; ++j) { v[j] = xr[64 * j]; s += (v[j].x * v[j].x + v[j].y * v[j].y) + (v[j].z * v[j].z + v[j].w * v[j].w); }
        const float rstd = 1.0f / sqrtf(wave_sum(s) * (1.0f / DM) + EPS);
        unsigned long long* o8 = (unsigned long long*)(H + (size_t)m * DM) + F.lane;
#pragma unroll
        for (int j = 0; j < 4; ++j) { const f32x4 gg = ((const f32x4*)g)[F.lane + 64 * j];
            o8[64 * j] = (unsigned long long)pk2(v[j].x * rstd * gg.x, v[j].y * rstd * gg.y) | ((unsigned long long)pk2(v[j].z * rstd * gg.z, v[j].w * rstd * gg.w) << 32); }
    }
}

__device__ __forceinline__ void p2_latent_norm(const Frame& F) {
    const KArgs ka = kargs();
    unsigned char* ws = F.ws; const float* ZB = (const float*)(ws + WS_ZB); const float* g_cq = (const float*)ka->in[7]; const float* g_ckv = (const float*)ka->in[8];
    const float* COS = (const float*)(ws + WS_COS); const float* SIN = (const float*)(ws + WS_SIN);
    for (int m = F.gw; m < T; m += F.NGW) {
        const float* zr = ZB + (size_t)m * 416; const int l = F.lane;
        const f32x4 cq = *(const f32x4*)(zr + 4 * l); const f32x2_t ck = *(const f32x2_t*)(zr + 256 + 2 * l); const float kr = zr[384 + (l & 31)];
        const float sq = wave_sum((cq.x * cq.x + cq.y * cq.y) + (cq.z * cq.z + cq.w * cq.w)), sk = wave_sum(ck.x * ck.x + ck.y * ck.y);
        const float rq = 1.0f / sqrtf(sq * (1.0f / 256) + EPS), rk = 1.0f / sqrtf(sk * (1.0f / 128) + EPS);
        const f32x4 gq = *(const f32x4*)(g_cq + 4 * l); const f32x2_t gk = *(const f32x2_t*)(g_ckv + 2 * l);
        *(unsigned long long*)((bf16*)(ws + WS_CQN) + (size_t)m * 256 + 4 * l) = (unsigned long long)pk2(cq.x * rq * gq.x, cq.y * rq * gq.y) | ((unsigned long long)pk2(cq.z * rq * gq.z, cq.w * rq * gq.w) << 32);
        *(unsigned*)((bf16*)(ws + WS_CKVN) + (size_t)m * 256 + 2 * l) = pk2(ck.x * rk * gk.x, ck.y * rk * gk.y);
        *(unsigned*)((bf16*)(ws + WS_CKVN) + (size_t)m * 256 + 128 + 2 * l) = 0u;
        const float other = __shfl_xor(kr, 16); const int i = l & 15; const float c = COS[(size_t)m * 16 + i], s = SIN[(size_t)m * 16 + i];
        const float rv = (l & 16) ? (other * s + kr * c) : (kr * c - other * s);
        if (l < 32) ((bf16*)(ws + WS_KR))[(size_t)m * 32 + l] = (bf16)(pk2(rv, 0.f) & 0xffffu);
    }
}

__device__ __forceinline__ void p5_group_norm(const Frame& F) {
    const KArgs ka = kargs();
    bf16* Y = (bf16*)(F.ws + WS_Y); const float* ga = (const float*)ka->in[11]; const float* gb = (const float*)ka->in[12];
    for (int m = F.gw; m < T; m += F.NGW) {
        v4u* yr = (v4u*)(Y + (size_t)m * 1024) + F.lane;
#pragma unroll
        for (int half = 0; half < 2; ++half) { const v4u w = yr[64 * half]; float f[8];
            f[0] = bf2f(w.x & 0xffff); f[1] = bf2f(w.x >> 16); f[2] = bf2f(w.y & 0xffff); f[3] = bf2f(w.y >> 16); f[4] = bf2f(w.z & 0xffff); f[5] = bf2f(w.z >> 16); f[6] = bf2f(w.w & 0xffff); f[7] = bf2f(w.w >> 16);
            float s = 0.f;
#pragma unroll
            for (int j = 0; j < 8; ++j) s += f[j] * f[j];
            const float rstd = 1.0f / sqrtf(wave_sum(s) * (1.0f / 512) + EPS);
            const float* g = (half ? gb : ga) + 8 * F.lane; const f32x4 g0 = *(const f32x4*)g, g1 = *(const f32x4*)(g + 4);
            v4u o; o.x = pk2(f[0] * rstd * g0.x, f[1] * rstd * g0.y); o.y = pk2(f[2] * rstd * g0.z, f[3] * rstd * g0.w); o.z = pk2(f[4] * rstd * g1.x, f[5] * rstd * g1.y); o.w = pk2(f[6] * rstd * g1.z, f[7] * rstd * g1.w);
            yr[64 * half] = o; }
    }
}

__device__ __forceinline__ void p7_ffn_norm_router(const Frame& F) {
    const KArgs ka = kargs();
    const float* x1 = ka->out; const float* g = (const float*)ka->in[14]; const float* w_router = (const float*)ka->in[15]; bf16* H = (bf16*)(F.ws + WS_HB); float* AFF = (float*)(F.ws + WS_AFF);
    f32x4* W4 = (f32x4*)F.lds;
    for (int idx = F.tid; idx < 16 * 4 * 64; idx += 512) { const int l = idx & 63, i = (idx >> 6) & 3, e = idx >> 8; f32x4 w;
#pragma unroll
        for (int j = 0; j < 4; ++j) w[j] = w_router[(size_t)(4 * l + 256 * j + i) * 16 + e];
        W4[idx] = w; }
    __syncthreads();
    for (int m = F.gw; m < T; m += F.NGW) {
        const f32x4* xr = (const f32x4*)(x1 + (size_t)m * DM) + F.lane; f32x4 v[4]; float s = 0.f;
#pragma unroll
        for (int j = 0; j < 4; ++j) { v[j] = xr[64 * j]; s += (v[j].x * v[j].x + v[j].y * v[j].y) + (v[j].z * v[j].z + v[j].w * v[j].w); }
        const float rstd = 1.0f / sqrtf(wave_sum(s) * (1.0f / DM) + EPS);
        unsigned long long* o8 = (unsigned long long*)(H + (size_t)m * DM) + F.lane;
#pragma unroll
        for (int j = 0; j < 4; ++j) { const f32x4 gg = ((const f32x4*)g)[F.lane + 64 * j]; v[j] = v[j] * rstd * gg;
            o8[64 * j] = (unsigned long long)pk2(v[j].x, v[j].y) | ((unsigned long long)pk2(v[j].z, v[j].w) << 32); }
        float lg[16];
#pragma unroll
        for (int e = 0; e < 16; ++e) { float acc = 0.f;
#pragma unroll
            for (int i = 0; i < 4; ++i) { const f32x4 w = W4[(e * 4 + i) * 64 + F.lane]; acc += v[0][i] * w[0] + v[1][i] * w[1] + v[2][i] * w[2] + v[3][i] * w[3]; }
            lg[e] = wave_sum(acc); asm volatile("" ::: "memory"); }
        float mx = lg[0];
#pragma unroll
        for (int e = 1; e < 16; ++e) mx = fmaxf(mx, lg[e]);
        float den = 0.f;
#pragma unroll
        for (int e = 0; e < 16; ++e) { lg[e] = __expf(lg[e] - mx); den += lg[e]; }
        const float rden = 1.0f / den; float mine = 0.f;
#pragma unroll
        for (int e = 0; e < 16; ++e) mine = (F.lane == e) ? lg[e] * rden : mine;
        if (F.lane < 16) AFF[((size_t)(m >> 11) * 16 + F.lane) * SEQ + (m & (SEQ - 1))] = mine;
    }
    __syncthreads();
}

__device__ __forceinline__ void p8_topk_gather(const Frame& F) {
    unsigned char* ws = F.ws; const float* AFF = (const float*)(ws + WS_AFF); int* INV = (int*)(ws + WS_INV); int* SEL = (int*)(ws + WS_SEL); float* VAL = (float*)(ws + WS_VAL);
    const bf16* H = (const bf16*)(ws + WS_HB); bf16* XG = (bf16*)(ws + WS_XG);
    unsigned long long* keys = (unsigned long long*)F.lds;
    for (int task = F.vcu; task < NBE; task += F.G) {
        const int b = task >> 4, e = task & 15;
        for (int i = F.tid; i < SEQ; i += 512) keys[i] = ((unsigned long long)__float_as_uint(AFF[(size_t)task * SEQ + i]) << 32) | (unsigned)(SEQ - 1 - i);
        __syncthreads();
        for (int k = 2; k <= SEQ; k <<= 1)
            for (int j = k >> 1; j > 0; j >>= 1) {
                for (int p = F.tid; p < SEQ / 2; p += 512) { const int i = ((p & ~(j - 1)) << 1) | (p & (j - 1)), l = i | j; const bool desc = (i & k) == 0;
                    const unsigned long long x = keys[i], y = keys[l]; if ((x < y) == desc) { keys[i] = y; keys[l] = x; } }
                __syncthreads();
            }
        for (int c = F.tid; c < SEQ; c += 512) { const unsigned long long kk = keys[c]; const int idx = SEQ - 1 - (int)(unsigned)(kk & 0xffffffffu);
            if (c < CAP) { SEL[task * CAP + c] = idx; VAL[task * CAP + c] = __uint_as_float((unsigned)(kk >> 32)); INV[((size_t)b * SEQ + idx) * 16 + e] = c; }
            else INV[((size_t)b * SEQ + idx) * 16 + e] = -1; }
        for (int c = F.wave * 32; c < F.wave * 32 + 32; ++c) { const int idx = SEQ - 1 - (int)(unsigned)(keys[c] & 0xffffffffu);
            const v4u* src = (const v4u*)(H + ((size_t)b * SEQ + idx) * DM) + F.lane; v4u* dst = (v4u*)(XG + ((size_t)task * CAP + c) * DM) + F.lane;
            const v4u r0 = src[0], r1 = src[64]; dst[0] = r0; dst[64] = r1; }
        __syncthreads();
    }
}

__device__ __forceinline__ void p11_combine_norm(const Frame& F) {
    const KArgs ka = kargs();
    unsigned char* ws = F.ws; float* xo = ka->out; const int* INV = (const int*)(ws + WS_INV); const bf16* OB = (const bf16*)(ws + WS_OB); bf16* H = (bf16*)(ws + WS_HB);
    const float* g = (const float*)ka->in[19]; const float* p = (const float*)ka->in[1]; bf16* PB = (bf16*)(ws + WS_PB);
    for (int m = F.gw; m < T; m += F.NGW) {
        f32x4* xr = (f32x4*)(xo + (size_t)m * DM) + F.lane; f32x4 v[4];
#pragma unroll
        for (int j = 0; j < 4; ++j) v[j] = xr[64 * j];
        const int inv = INV[(size_t)m * 16 + (F.lane & 15)]; const int b = m >> 11;
        for (int e = 0; e < 16; ++e) { const int c = __builtin_amdgcn_readlane(inv, e);
            if (c >= 0) { const v2u* orow = (const v2u*)(OB + ((size_t)(b * 16 + e) * CAP + c) * DM) + F.lane;
#pragma unroll
                for (int j = 0; j < 4; ++j) { const v2u w = orow[64 * j]; v[j].x += bf2f(w.x & 0xffff); v[j].y += bf2f(w.x >> 16); v[j].z += bf2f(w.y & 0xffff); v[j].w += bf2f(w.y >> 16); } } }
        float s = 0.f;
#pragma unroll
        for (int j = 0; j < 4; ++j) { xr[64 * j] = v[j]; s += (v[j].x * v[j].x + v[j].y * v[j].y) + (v[j].z * v[j].z + v[j].w * v[j].w); }
        const float rstd = 1.0f / sqrtf(wave_sum(s) * (1.0f / DM) + EPS);
        unsigned long long* o8 = (unsigned long long*)(H + (size_t)m * DM) + F.lane;
#pragma unroll
        for (int j = 0; j < 4; ++j) { const f32x4 gg = ((const f32x4*)g)[F.lane + 64 * j];
            o8[64 * j] = (unsigned long long)pk2(v[j].x * rstd * gg.x, v[j].y * rstd * gg.y) | ((unsigned long long)pk2(v[j].z * rstd * gg.z, v[j].w * rstd * gg.w) << 32); }
        const f32x4 pv = ((const f32x4*)(p + (size_t)m * PLE))[F.lane];
        ((unsigned long long*)(PB + (size_t)m * PLE))[F.lane] = (unsigned long long)pk2(pv.x, pv.y) | ((unsigned long long)pk2(pv.z, pv.w) << 32);
    }
}

__device__ __forceinline__ void p13_final_norm(const Frame& F) {
    const KArgs ka = kargs();
    float* xo = ka->out; const float* g = (const float*)ka->in[22];
    for (int m = F.gw; m < T; m += F.NGW) {
        f32x4* xr = (f32x4*)(xo + (size_t)m * DM) + F.lane; f32x4 v[4]; float s = 0.f;
#pragma unroll
        for (int j = 0; j < 4; ++j) { v[j] = xr[64 * j]; s += (v[j].x * v[j].x + v[j].y * v[j].y) + (v[j].z * v[j].z + v[j].w * v[j].w); }
        const float rstd = 1.0f / sqrtf(wave_sum(s) * (1.0f / DM) + EPS);
#pragma unroll
        for (int j = 0; j < 4; ++j) { const f32x4 gg = ((const f32x4*)g)[F.lane + 64 * j]; xr[64 * j] = v[j] * rstd * gg; }
    }
}

#ifndef PHMASK
#define PHMASK 0x7ffff
#endif
__global__ void __launch_bounds__(NWAVES * 64, 2) fwd_kernel(Args args) {
    extern __shared__ __attribute__((aligned(16))) unsigned char lds[];
    Frame F;
    F.lds = (char*)lds; F.tid = threadIdx.x; F.lane = F.tid & 63; F.wave = __builtin_amdgcn_readfirstlane(F.tid >> 6);
    F.G = gridDim.x; { const int bx = blockIdx.x; F.vcu = (F.G % 8 == 0) ? (bx % 8) * (F.G / 8) + bx / 8 : bx; }
    F.gw = F.vcu * NWAVES + F.wave; F.NGW = F.G * NWAVES; F.ws = args.ws;
    unsigned char* ws = args.ws;
    volatile LAS unsigned* MISC = (volatile LAS unsigned*)((LAS unsigned char*)lds + MISC_OFF);
    if (F.tid < 16) MISC[F.tid] = 0u;
    __syncthreads();
    XcdBarrier bar = xcd_barrier_post((unsigned*)(ws + WS_CTL) + CW_BAR, MISC + 8);
    PG8_LAS unsigned char* ring = (PG8_LAS unsigned char*)lds;
    const int G = F.G, bx = (int)blockIdx.x;

    if (PHMASK & 1) p0_prologue(F);
    xcd_barrier(bar);
    if (PHMASK & 2) { pg8::Gemm g{(const bf16*)(ws + WS_HB), (const bf16*)(ws + WS_WIN), T, IN_PAD, DM}; pg8::StaticOrder S; S.init(T, IN_PAD, G, bx);
      pg8::EpiZ E{(bf16*)(ws + WS_QA), (bf16*)(ws + WS_KVA), (float*)(ws + WS_ZB)};
      pg8::gemm_phase<pg8::EpiZ, pg8::StaticOrder, true, true>(ring, g, S, E); }
    xcd_barrier(bar);
    if (PHMASK & 4) p2_latent_norm(F);
    xcd_barrier(bar);
    if (PHMASK & 8) { pg8::Gemm g{(const bf16*)(ws + WS_CQN), (const bf16*)(ws + WS_WUQ), T, 768, 256}; pg8::StaticOrder S; S.init(T, 768, G, bx);
      pg8::EpiBf<768> E{(bf16*)(ws + WS_QB)};
      pg8::gemm_phase<pg8::EpiBf<768>, pg8::StaticOrder, true, true>(ring, g, S, E); }
    if (PHMASK & 0x20000) { pg8::Gemm g{(const bf16*)(ws + WS_CKVN), (const bf16*)(ws + WS_WUKV), T, 1024, 256}; pg8::StaticOrder S; S.init(T, 1024, G, bx);
      pg8::EpiBf<1024> E{(bf16*)(ws + WS_KVB)};
      pg8::gemm_phase<pg8::EpiBf<1024>, pg8::StaticOrder, true, true>(ring, g, S, E); }
    xcd_barrier(bar);
    if (PHMASK & 16) { const bf16* QB = (const bf16*)(ws + WS_QB); const bf16* KVB = (const bf16*)(ws + WS_KVB); const bf16* KR = (const bf16*)(ws + WS_KR); bf16* Y = (bf16*)(ws + WS_Y);
      for (int u = F.vcu; u < 512; u += G) { const int qb = u & 7, bh = u >> 3;
          att::mla::unit(bh >> 3, bh & 7, qb, QB, KVB, KR, (const float*)(ws + WS_COS), (const float*)(ws + WS_SIN), Y, (char*)lds); }
      if (PHMASK & 0x10000) for (int u = F.vcu; u < 512; u += G) { const int qb = u & 7, bh = u >> 3;
          att::wnd::unit(bh >> 3, bh & 7, qb, (const bf16*)(ws + WS_QA), (const bf16*)(ws + WS_KVA), (const float*)kargs()->in[3], (const float*)kargs()->in[6], Y, (char*)lds); } }
    xcd_barrier(bar);
    if (PHMASK & 32) p5_group_norm(F);
    xcd_barrier(bar);
    if (PHMASK & 64) { pg8::Gemm g{(const bf16*)(ws + WS_Y), (const bf16*)(ws + WS_WOUT), T, DM, DM}; pg8::StaticOrder S; S.init(T, DM, G, bx);
      const KArgs ka = kargs(); pg8::EpiRes E{(const float*)ka->in[0], ka->out};
      pg8::gemm_phase<pg8::EpiRes, pg8::StaticOrder, true, true>(ring, g, S, E); }
    xcd_barrier(bar);
    if (PHMASK & 128) p7_ffn_norm_router(F);
    xcd_barrier(bar);
    if (PHMASK & 256) p8_topk_gather(F);
    xcd_barrier(bar);
    if (PHMASK & 512) { pg8::Gemm g{(const bf16*)(ws + WS_XG), (const bf16*)(ws + WS_WGU), NBE * CAP, 1024, DM}; pg8::StaticOrder S; S.init(NBE * CAP, 1024, G, bx); S.bexp = 16;
      pg8::EpiSwiGLU E{(bf16*)(ws + WS_ACT)};
      pg8::gemm_phase<pg8::EpiSwiGLU, pg8::StaticOrder, true, true>(ring, g, S, E); }
    xcd_barrier(bar);
    if (PHMASK & 1024) { pg8::Gemm g{(const bf16*)(ws + WS_ACT), (const bf16*)(ws + WS_WD), NBE * CAP, 1024, FF}; pg8::StaticOrder S; S.init(NBE * CAP, 1024, G, bx); S.bexp = 16;
      pg8::EpiDown E{(bf16*)(ws + WS_OB), (const float*)(ws + WS_VAL)};
      pg8::gemm_phase<pg8::EpiDown, pg8::StaticOrder, true, true>(ring, g, S, E); }
    xcd_barrier(bar);
    if (PHMASK & 2048) p11_combine_norm(F);
    xcd_barrier(bar);
    if (PHMASK & 4096) { pg8::Gemm g{(const bf16*)(ws + WS_PB), (const bf16*)(ws + WS_WPP), T, DM, PLE}; pg8::StaticOrder S; S.init(T, DM, G, bx);
      pg8::EpiBf<1024> E{(bf16*)(ws + WS_PROJ)};
      pg8::gemm_phase<pg8::EpiBf<1024>, pg8::StaticOrder, true, true>(ring, g, S, E); }
    if (PHMASK & 0x40000) { pg8::Gemm g{(const bf16*)(ws + WS_HB), (const bf16*)(ws + WS_WPG), T, DM, DM}; pg8::StaticOrder S; S.init(T, DM, G, bx);
      pg8::EpiPle E{kargs()->out, (const bf16*)(ws + WS_PROJ)};
      pg8::gemm_phase<pg8::EpiPle, pg8::StaticOrder, true, true>(ring, g, S, E); }
    xcd_barrier(bar);
    if (PHMASK & 8192) p13_final_norm(F);
}

extern "C" void kernel_launch(void* const* d_in, const int* in_sizes, int n_in, void* d_out, int out_size, void* d_ws, size_t ws_size, hipStream_t stream) {
    static int grid = 0;
    if (grid == 0) {
        if (n_in != 23 || in_sizes[0] != T * DM || out_size != T * DM || ws_size < WS_END) { fprintf(stderr, "kernel_launch: unexpected shapes: n_in %d in0 %d out %d ws %zu (need %zu)\n", n_in, n_in > 0 ? in_sizes[0] : -1, out_size, ws_size, (size_t)WS_END); grid = -1; return; }
        int dev = 0, cus = 0, per_cu = 0;
        if (hipGetDevice(&dev) != hipSuccess || hipDeviceGetAttribute(&cus, hipDeviceAttributeMultiprocessorCount, dev) != hipSuccess) { fprintf(stderr, "kernel_launch: device query failed\n"); grid = -1; return; }
        if (hipFuncSetAttribute((const void*)fwd_kernel, hipFuncAttributeMaxDynamicSharedMemorySize, LDS_BYTES) != hipSuccess) { fprintf(stderr, "kernel_launch: hipFuncSetAttribute failed\n"); grid = -1; return; }
        if (hipOccupancyMaxActiveBlocksPerMultiprocessor(&per_cu, (const void*)fwd_kernel, NWAVES * 64, LDS_BYTES) != hipSuccess || per_cu < 1) { fprintf(stderr, "kernel_launch: occupancy query says %d workgroups per CU\n", per_cu); (void)hipGetLastError(); }
        grid = cus;
    }
    if (grid < 0) return;
    if (hipMemsetAsync((char*)d_ws + WS_CTL, 0, CTL_ZERO_BYTES, stream) != hipSuccess) { fprintf(stderr, "kernel_launch: hipMemsetAsync failed\n"); return; }
    Args a{};
    for (int i = 0; i < 23; ++i) a.in[i] = d_in[i];
    a.out = (float*)d_out; a.ws = (unsigned char*)d_ws;
    hipLaunchKernelGGL(fwd_kernel, dim3(grid), dim3(NWAVES * 64), LDS_BYTES, stream, a);
    const hipError_t le = hipPeekAtLastError();
    if (le != hipSuccess) fprintf(stderr, "kernel_launch: launch failed: %s\n", hipGetErrorName(le));
}
```

```cpp
#include <hip/hip_runtime.h>
#include <hip/hip_bf16.h>
#include <cstdio>
#include <cstdint>

constexpr int BATCH = 8, SEQ = 2048, DM = 1024, T = BATCH * SEQ;
constexpr int IN_COLS = 1184, IN_PAD = 1280;
constexpr int NE = 16, FF = 512, CAP = 256, NBE = BATCH * NE;
constexpr int PLE = 256;
constexpr float EPS = 1e-6f;
constexpr float LOG2E = 1.4426950408889634f;

struct Args { const void* in[23]; float* out; unsigned char* ws; };
typedef const __attribute__((address_space(4))) Args* KArgs;
__device__ __forceinline__ KArgs kargs() { KArgs p = (KArgs)__builtin_amdgcn_kernarg_segment_ptr(); asm volatile("" : "+s"(p)); return p; }

constexpr size_t MiB = 1u << 20, KiB = 1u << 10;
constexpr size_t WS_CTL = 0, CTL_ZERO_BYTES = 64 * KiB;
constexpr size_t WS_WIN = 1 * MiB;
constexpr size_t WS_WUQ = WS_WIN + (size_t)IN_PAD * DM * 2;
constexpr size_t WS_WUKV = WS_WUQ + 768 * 256 * 2;
constexpr size_t WS_WOUT = WS_WUKV + 1024 * 256 * 2;
constexpr size_t WS_WPG = WS_WOUT + 2 * MiB;
constexpr size_t WS_WPP = WS_WPG + 2 * MiB;
constexpr size_t WS_WGU = 9 * MiB;
constexpr size_t WS_WD = WS_WGU + 32 * MiB;
constexpr size_t WS_COS = WS_WD + 16 * MiB, WS_SIN = WS_COS + 1 * MiB;
constexpr size_t WS_AFF = WS_SIN + 1 * MiB;
constexpr size_t WS_INV = WS_AFF + 1 * MiB;
constexpr size_t WS_SEL = WS_INV + 1 * MiB;
constexpr size_t WS_VAL = WS_SEL + 128 * KiB;
constexpr size_t WS_HB = 62 * MiB;
constexpr size_t WS_Y = 94 * MiB;
constexpr size_t WS_R1 = 126 * MiB;
constexpr size_t WS_QA = WS_R1;
constexpr size_t WS_KVA = WS_QA + 16 * MiB;
constexpr size_t WS_ZB = WS_KVA + 8 * MiB;
constexpr size_t WS_CQN = WS_ZB + 26 * MiB;
constexpr size_t WS_CKVN = WS_CQN + 8 * MiB;
constexpr size_t WS_KR = WS_CKVN + 8 * MiB;
constexpr size_t WS_QB = WS_KR + 1 * MiB;
constexpr size_t WS_KVB = WS_QB + 24 * MiB;
constexpr size_t WS_XG = WS_R1;
constexpr size_t WS_ACT = WS_R1 + 64 * MiB;
constexpr size_t WS_OB = WS_R1;
constexpr size_t WS_PROJ = WS_R1 + 64 * MiB;
constexpr size_t WS_PB = WS_R1 + 96 * MiB;
constexpr size_t WS_END = 254 * MiB;
static_assert(WS_WPP + 1024 * 256 * 2 <= WS_WGU && WS_VAL + 128 * KiB <= WS_HB && WS_KVB + 32 * MiB <= WS_END && WS_PB + 8 * MiB <= WS_END, "d_ws map");
constexpr int CW_BAR = 1024;

constexpr int RING_BYTES = 131072;
constexpr int MISC_OFF = RING_BYTES;
constexpr int XTRA_OFF = RING_BYTES + 256;
constexpr int LDS_BYTES = 147456;
constexpr int NWAVES = 8;


namespace pg8 {
#define PG8_LAS __attribute__((address_space(3)))
typedef unsigned short bf16_t;
typedef short bf16x8 __attribute__((ext_vector_type(8)));
typedef float f32x4 __attribute__((ext_vector_type(4)));
typedef unsigned u32x4 __attribute__((ext_vector_type(4)));
constexpr int BM = 256, BK = 64, HALF = 128, HTB = HALF * BK * 2  , STAGE_BYTES = 8 * HTB, NXCD = 8, WGM = 8;

__host__ __device__ __forceinline__ int lds_byte(int r, int c) { const int st = (r >> 4) * 2 + (c >> 5), rr = r & 15, cc = c & 31, ob = rr * 64 + cc * 2; return st * 1024 + (ob ^ (((ob >> 9) & 1) << 5)); }
__host__ __device__ __forceinline__ void stage_rc(int b, int& R, int& C) { const int st = b / 1024, sb = b % 1024, swz = sb ^ (((sb >> 9) & 1) << 5); R = (st >> 1) * 16 + swz / 64; C = (st & 1) * 32 + (swz % 64) / 2; }
__host__ __device__ __forceinline__ int perm32(int rho) { const int n = rho >> 4, i = rho & 15; return 8 * (i >> 2) + 4 * n + (i & 3); }

struct Unit { int pm, pn; };
struct Gemm { const bf16_t* A; const bf16_t* Bt; int M, N, K; };

struct StaticOrder {
    int nM, nN, nwg, G, c, bexp;
    __host__ __device__ void init(int M, int N, int G_, int c_) { nM = M / BM; nN = N / BM; nwg = nM * nN; G = G_; c = c_; bexp = 0; }
    __host__ __device__ bool next(int i, Unit& u) const {
        const long L = (long)i * G + c; if (L >= nwg) return false;
        int wgid = (int)L; { const int q = nwg / NXCD, r = nwg % NXCD, xcd = wgid % NXCD, off = wgid / NXCD; wgid = (xcd < r ? xcd * (q + 1) : r * (q + 1) + (xcd - r) * q) + off; }
        const int nig = WGM * nN, gid = wgid / nig, fm = gid * WGM, gsz = (nM - fm) < WGM ? (nM - fm) : WGM;
        u.pm = fm + ((wgid % nig) % gsz); u.pn = (wgid % nig) / gsz; return true;
    }
    __device__ __forceinline__ int btile(const Unit& u) const { return bexp ? (u.pm & (bexp - 1)) * nN + u.pn : u.pn; }
    __device__ __forceinline__ void a_ready(const Unit&) const {}
    __device__ __forceinline__ void done(const Unit&) const {}
};


__device__ __forceinline__ unsigned cvt_pk_bf16(float lo, float hi) { unsigned r; asm volatile("v_cvt_pk_bf16_f32 %0, %1, %2" : "=v"(r) : "v"(lo), "v"(hi)); return r; }
#define EPI_DEFAULTS struct State {}; static constexpr bool HAS_MID = false, AFTER_DRAIN = false; static constexpr int MID_T = 0; \
    __device__ __forceinline__ void pre(State&, const Unit&, int, int, int, int) const {} \
    __device__ __forceinline__ void mid(State&, f32x4 (&)[2][2][4][2], const Unit&, int, int, int, int) const {}
__device__ __forceinline__ u32x4 pack8(const f32x4 v0, const f32x4 v1) { u32x4 w; w.x = cvt_pk_bf16(v0[0], v0[1]); w.y = cvt_pk_bf16(v0[2], v0[3]); w.z = cvt_pk_bf16(v1[0], v1[1]); w.w = cvt_pk_bf16(v1[2], v1[3]); return w; }
__device__ __forceinline__ float bflo(unsigned w) { return __builtin_bit_cast(float, w << 16); }
__device__ __forceinline__ float bfhi(unsigned w) { return __builtin_bit_cast(float, w & 0xffff0000u); }

struct EpiZ {
    static constexpr bool PERM = true; EPI_DEFAULTS
    unsigned char* ws;
    __device__ __forceinline__ void operator()(State&, const f32x4 (&acc)[2][2][4][2], const Unit& u, int wr, int wc, int fr, int fq) const {
        const int row0 = u.pm * BM + wr * 64 + fr, c8 = wc * 32 + 8 * fq;
        bf16_t* QA = (bf16_t*)(ws + WS_QA); bf16_t* KVA = (bf16_t*)(ws + WS_KVA);
        if (u.pn < 3) {
#pragma unroll
            for (int ai = 0; ai < 2; ++ai)
#pragma unroll
                for (int m = 0; m < 4; ++m) { const size_t row = (size_t)(row0 + ai * HALF + m * 16);
#pragma unroll
                    for (int bj = 0; bj < 2; ++bj) { const int col = bj * HALF + c8; const f32x4 v0 = acc[ai][bj][m][0], v1 = acc[ai][bj][m][1];
                        if (u.pn < 2) *(u32x4*)(QA + row * 512 + u.pn * 256 + col) = pack8(v0, v1);
                        else *(u32x4*)(KVA + row * 256 + col) = pack8(v0, v1); } }
            return;
        }
        const bool cq = (u.pn == 3);
        bf16_t* CQN = (bf16_t*)(ws + WS_CQN); bf16_t* CKVN = (bf16_t*)(ws + WS_CKVN); bf16_t* KR = (bf16_t*)(ws + WS_KR); const float* COS = (const float*)(ws + WS_COS); const float* SIN = (const float*)(ws + WS_SIN);
        const KArgs ka = kargs(); const float* g_cq = (const float*)ka->in[7]; const float* g_ckv = (const float*)ka->in[8];
        PG8_LAS float* P = (PG8_LAS float*)(XTRA_OFF);
#pragma unroll
        for (int ai = 0; ai < 2; ++ai)
#pragma unroll
            for (int m = 0; m < 4; ++m) { float s = 0.f;
#pragma unroll
                for (int bj = 0; bj < 2; ++bj) { if (bj == 1 && !cq) continue;
#pragma unroll
                    for (int n = 0; n < 2; ++n) { const f32x4 x = acc[ai][bj][m][n]; s += (x[0] * x[0] + x[1] * x[1]) + (x[2] * x[2] + x[3] * x[3]); } }
                s += __shfl_xor(s, 16); s += __shfl_xor(s, 32);
                if (fq == 0) P[(ai * HALF + wr * 64 + m * 16 + fr) * 4 + wc] = s; }
        asm volatile("s_waitcnt lgkmcnt(0)" ::: "memory"); __builtin_amdgcn_s_barrier(); asm volatile("" ::: "memory");
        const float inv_n = cq ? (1.0f / 256.0f) : (1.0f / 128.0f);
        f32x4 gv[2][2];
#pragma unroll
        for (int bj = 0; bj < 2; ++bj)
#pragma unroll
            for (int n = 0; n < 2; ++n) gv[bj][n] = cq ? *(const f32x4*)(g_cq + bj * HALF + c8 + 4 * n) : *(const f32x4*)(g_ckv + c8 + 4 * n);
#pragma unroll
        for (int ai = 0; ai < 2; ++ai)
#pragma unroll
            for (int m = 0; m < 4; ++m) { const int rl = ai * HALF + wr * 64 + m * 16 + fr; const size_t row = (size_t)(u.pm * BM + rl);
                const f32x4 pp = *(const PG8_LAS f32x4*)(P + rl * 4); const float rstd = 1.0f / sqrtf(((pp[0] + pp[1]) + (pp[2] + pp[3])) * inv_n + 1e-6f);
                if (cq) {
#pragma unroll
                    for (int bj = 0; bj < 2; ++bj) *(u32x4*)(CQN + row * 256 + bj * HALF + c8) = pack8(acc[ai][bj][m][0] * rstd * gv[bj][0], acc[ai][bj][m][1] * rstd * gv[bj][1]);
                } else {
                    *(u32x4*)(CKVN + row * 256 + c8) = pack8(acc[ai][0][m][0] * rstd * gv[0][0], acc[ai][0][m][1] * rstd * gv[0][1]);
                    *(u32x4*)(CKVN + row * 256 + HALF + c8) = (u32x4){0u, 0u, 0u, 0u};
                    if (wc == 0) { f32x4 mine0 = acc[ai][1][m][0], mine1 = acc[ai][1][m][1], oth0, oth1;
#pragma unroll
                        for (int i = 0; i < 4; ++i) { oth0[i] = __shfl_xor(mine0[i], 32); oth1[i] = __shfl_xor(mine1[i], 32); }
                        const int j0 = 8 * (fq & 1); const f32x4 cs0 = *(const f32x4*)(COS + row * 16 + j0), cs1 = *(const f32x4*)(COS + row * 16 + j0 + 4), sn0 = *(const f32x4*)(SIN + row * 16 + j0), sn1 = *(const f32x4*)(SIN + row * 16 + j0 + 4);
                        f32x4 r0, r1;
                        if (fq < 2) { r0 = mine0 * cs0 - oth0 * sn0; r1 = mine1 * cs1 - oth1 * sn1; }
                        else { r0 = oth0 * sn0 + mine0 * cs0; r1 = oth1 * sn1 + mine1 * cs1; }
                        *(u32x4*)(KR + row * 32 + 8 * fq) = pack8(r0, r1); } } }
    }
};
template <int ldc> struct EpiBf {
    static constexpr bool PERM = true; EPI_DEFAULTS
    bf16_t* O;
    __device__ __forceinline__ void operator()(State&, const f32x4 (&acc)[2][2][4][2], const Unit& u, int wr, int wc, int fr, int fq) const {
        const int row0 = u.pm * BM + wr * 64 + fr, c8 = u.pn * BM + wc * 32 + 8 * fq;
#pragma unroll
        for (int ai = 0; ai < 2; ++ai)
#pragma unroll
            for (int m = 0; m < 4; ++m) { bf16_t* rowp = O + (size_t)(row0 + ai * HALF + m * 16) * ldc + c8;
#pragma unroll
                for (int bj = 0; bj < 2; ++bj) *(u32x4*)(rowp + bj * HALF) = pack8(acc[ai][bj][m][0], acc[ai][bj][m][1]); }
    }
};
struct EpiRes {
    static constexpr bool PERM = false; EPI_DEFAULTS
    const float* base; float* out;
    __device__ __forceinline__ void operator()(State&, const f32x4 (&acc)[2][2][4][2], const Unit& u, int wr, int wc, int fr, int fq) const {
        const int row0 = u.pm * BM + wr * 64 + fr, c4 = u.pn * BM + wc * 32 + 4 * fq;
#pragma unroll
        for (int ai = 0; ai < 2; ++ai)
#pragma unroll
            for (int m = 0; m < 4; ++m) { const size_t off = (size_t)(row0 + ai * HALF + m * 16) * 1024 + c4;
#pragma unroll
                for (int bj = 0; bj < 2; ++bj)
#pragma unroll
                    for (int n = 0; n < 2; ++n) { const f32x4 b = *(const f32x4*)(base + off + bj * HALF + n * 16); *(f32x4*)(out + off + bj * HALF + n * 16) = b + acc[ai][bj][m][n]; } }
    }
};
struct EpiSwiGLU {
    static constexpr bool PERM = true; EPI_DEFAULTS
    bf16_t* ACT;
    __device__ __forceinline__ void operator()(State&, const f32x4 (&acc)[2][2][4][2], const Unit& u, int wr, int wc, int fr, int fq) const {
        const int row0 = u.pm * BM + wr * 64 + fr, c8 = u.pn * HALF + wc * 32 + 8 * fq;
#pragma unroll
        for (int ai = 0; ai < 2; ++ai)
#pragma unroll
            for (int m = 0; m < 4; ++m) { f32x4 r[2];
#pragma unroll
                for (int n = 0; n < 2; ++n)
#pragma unroll
                    for (int i = 0; i < 4; ++i) { const float g = acc[ai][0][m][n][i], up = acc[ai][1][m][n][i]; r[n][i] = g * __builtin_amdgcn_rcpf(1.0f + __expf(-g)) * up; }
                *(u32x4*)(ACT + (size_t)(row0 + ai * HALF + m * 16) * 512 + c8) = pack8(r[0], r[1]); }
    }
};
struct EpiDown {
    static constexpr bool PERM = true; EPI_DEFAULTS
    bf16_t* OB; const float* VAL;
    __device__ __forceinline__ void operator()(State&, const f32x4 (&acc)[2][2][4][2], const Unit& u, int wr, int wc, int fr, int fq) const {
        const int row0 = u.pm * BM + wr * 64 + fr, c8 = u.pn * BM + wc * 32 + 8 * fq;
#pragma unroll
        for (int ai = 0; ai < 2; ++ai)
#pragma unroll
            for (int m = 0; m < 4; ++m) { const int row = row0 + ai * HALF + m * 16; const float s = VAL[row]; bf16_t* rowp = OB + (size_t)row * 1024 + c8;
#pragma unroll
                for (int bj = 0; bj < 2; ++bj) *(u32x4*)(rowp + bj * HALF) = pack8(acc[ai][bj][m][0] * s, acc[ai][bj][m][1] * s); }
    }
};
struct EpiPle {
    static constexpr bool PERM = true; EPI_DEFAULTS
    float* out; const bf16_t* PROJ;
    __device__ __forceinline__ void operator()(State&, const f32x4 (&acc)[2][2][4][2], const Unit& u, int wr, int wc, int fr, int fq) const {
        const int row0 = u.pm * BM + wr * 64 + fr, c8 = u.pn * BM + wc * 32 + 8 * fq;
#pragma unroll
        for (int ai = 0; ai < 2; ++ai)
#pragma unroll
            for (int m = 0; m < 4; ++m) { const size_t off = (size_t)(row0 + ai * HALF + m * 16) * 1024 + c8;
#pragma unroll
                for (int bj = 0; bj < 2; ++bj) { float* op = out + off + bj * HALF; const u32x4 pw = *(const u32x4*)(PROJ + off + bj * HALF);
                    const f32x4 x0 = *(const f32x4*)op, x1 = *(const f32x4*)(op + 4); const f32x4 a0 = acc[ai][bj][m][0], a1 = acc[ai][bj][m][1];
                    f32x4 g0, g1;
#pragma unroll
                    for (int i = 0; i < 4; ++i) { g0[i] = __builtin_amdgcn_rcpf(1.0f + __expf(-a0[i])); g1[i] = __builtin_amdgcn_rcpf(1.0f + __expf(-a1[i])); }
                    f32x4 r0, r1;
                    r0[0] = x0[0] + g0[0] * bflo(pw.x); r0[1] = x0[1] + g0[1] * bfhi(pw.x); r0[2] = x0[2] + g0[2] * bflo(pw.y); r0[3] = x0[3] + g0[3] * bfhi(pw.y);
                    r1[0] = x1[0] + g1[0] * bflo(pw.z); r1[1] = x1[1] + g1[1] * bfhi(pw.z); r1[2] = x1[2] + g1[2] * bflo(pw.w); r1[3] = x1[3] + g1[3] * bfhi(pw.w);
                    *(f32x4*)op = r0; *(f32x4*)(op + 4) = r1; } }
    }
};

template <class Epi, class Sched, bool ALIGN_EPI = false, bool GATHER = false>
__device__ __forceinline__ void gemm_phase(PG8_LAS unsigned char* lds, const Gemm g, const Sched& S, const Epi& E, const PG8_LAS int* gtab = nullptr) {
    int tid_ = threadIdx.x; asm volatile("" : "+v"(tid_));
    const int tid = tid_, wid = __builtin_amdgcn_readfirstlane(tid >> 6), lane = tid & 63, wr = wid >> 2, wc = wid & 3, fr = lane & 15, fq = lane >> 4;
    const int K = g.K, nt = K / BK;
    unsigned voffA[2], voffB[2]; int stR[2], stC[2];
#pragma unroll
    for (int i = 0; i < 2; ++i) { int R, C; stage_rc(tid * 16 + i * 8192, R, C); const int Rb = Epi::PERM ? ((R & ~31) + perm32(R & 31)) : R; stR[i] = R; stC[i] = C;
        voffA[i] = (unsigned)(R * K + C) * 2u; voffB[i] = (unsigned)(Rb * K + C) * 2u; }
    const size_t kstep = (size_t)(BK * 2);
    const size_t hstep = (size_t)HALF * K * 2;
    const size_t tstep = 2 * hstep;
    const unsigned ldsw = (unsigned)wid * 1024u;
    const int aoff = lds_byte(wr * 64 + fr, fq * 8), boff = lds_byte(wc * 32 + fr, fq * 8);
#define PG8_SA(b, h) (((b) * 2 + (h)) * HTB)
#define PG8_SB(b, h) ((4 + (b) * 2 + (h)) * HTB)
#define PG8_STAGE(bufoff, gbase, voff) do { _Pragma("unroll") for (int _i = 0; _i < 2; ++_i) \
        __builtin_amdgcn_global_load_lds((const unsigned*)((const char*)(gbase) + (voff)[_i]), (PG8_LAS unsigned*)(lds + (bufoff) + ldsw + _i * 8192), 16, 0, 0); } while (0)
#define PG8_STAGE_A(bufoff, ub, uo, h, ko) do { if constexpr (GATHER) { PG8_STAGE(bufoff, (const char*)g.A + (ko), (uo)[h]); } else { PG8_STAGE(bufoff, (ub) + (size_t)(h) * hstep + (ko), voffA); } } while (0)
#define PG8_LDA(dst, b, h) do { _Pragma("unroll") for (int m = 0; m < 4; ++m) _Pragma("unroll") for (int k = 0; k < 2; ++k) dst[m][k] = *(const PG8_LAS bf16x8*)(lds + PG8_SA(b, h) + aoff + m * 2048 + k * 1024); } while (0)
#define PG8_LDB(dst, b, h) do { _Pragma("unroll") for (int n = 0; n < 2; ++n) _Pragma("unroll") for (int k = 0; k < 2; ++k) dst[n][k] = *(const PG8_LAS bf16x8*)(lds + PG8_SB(b, h) + boff + n * 2048 + k * 1024); } while (0)
#define PG8_MMA(ai, bj, At, Bt) do { __builtin_amdgcn_s_setprio(1); _Pragma("unroll") for (int m = 0; m < 4; ++m) _Pragma("unroll") for (int n = 0; n < 2; ++n) _Pragma("unroll") for (int k = 0; k < 2; ++k) \
        acc[ai][bj][m][n] = __builtin_amdgcn_mfma_f32_16x16x32_bf16(Bt[n][k], At[m][k], acc[ai][bj][m][n], 0, 0, 0); __builtin_amdgcn_s_setprio(0); } while (0)
#define PG8_WAIT_V(n) asm volatile("s_waitcnt vmcnt(" #n ")" ::: "memory")
#define PG8_WAIT_L(n) asm volatile("s_waitcnt lgkmcnt(" #n ")" ::: "memory")
#define PG8_BAR __builtin_amdgcn_s_barrier()
#define PG8_SCHED __builtin_amdgcn_sched_barrier(0)
#define PG8_GOFF(dst, uix) do { if constexpr (GATHER) { _Pragma("unroll") for (int _h = 0; _h < 2; ++_h) _Pragma("unroll") for (int _i = 0; _i < 2; ++_i) \
        dst[_h][_i] = (unsigned)(gtab[(uix) * 256 + _h * HALF + stR[_i]] * K + stC[_i]) * 2u; } } while (0)
    Unit cur, nxt; int ui = 0;
    if (!S.next(0, cur)) return;
    f32x4 acc[2][2][4][2];
#pragma unroll
    for (int a = 0; a < 2; ++a)
#pragma unroll
        for (int b = 0; b < 2; ++b)
#pragma unroll
            for (int m = 0; m < 4; ++m)
#pragma unroll
                for (int n = 0; n < 2; ++n) acc[a][b][m][n] = (f32x4){0.f, 0.f, 0.f, 0.f};
    bf16x8 At[4][2], B0[2][2], B1[2][2];
    unsigned co[2][2] = {{0u, 0u}, {0u, 0u}}, no[2][2] = {{0u, 0u}, {0u, 0u}};
    PG8_GOFF(co, 0);
    typename Epi::State st;
    const char* cA = (const char*)g.A + (size_t)cur.pm * tstep; const char* cB = (const char*)g.Bt + (size_t)S.btile(cur) * tstep;
    S.a_ready(cur);
    PG8_STAGE(PG8_SB(0, 0), cB, voffB); PG8_STAGE(PG8_SB(0, 1), cB + hstep, voffB); PG8_STAGE_A(PG8_SA(0, 0), cA, co, 0, 0); PG8_STAGE_A(PG8_SA(0, 1), cA, co, 1, 0);
    if (wr == 1) PG8_BAR;
    PG8_WAIT_V(2); PG8_BAR;
    PG8_STAGE(PG8_SB(1, 0), cB + kstep, voffB); PG8_STAGE_A(PG8_SA(1, 0), cA, co, 0, kstep); PG8_STAGE(PG8_SB(1, 1), cB + hstep + kstep, voffB);
    PG8_WAIT_V(6); PG8_BAR;
    for (;;) {
        const bool has_next = S.next(ui + 1, nxt);
        const char* nA = has_next ? (const char*)g.A + (size_t)nxt.pm * tstep : cA; const char* nB = has_next ? (const char*)g.Bt + (size_t)S.btile(nxt) * tstep : cB;
        if constexpr (GATHER) { if (has_next) PG8_GOFF(no, ui + 1); else {
#pragma unroll
            for (int h = 0; h < 2; ++h)
#pragma unroll
                for (int i = 0; i < 2; ++i) no[h][i] = co[h][i]; } }
        E.pre(st, cur, wr, wc, fr, fq);
#pragma nounroll
        for (int t = 0; t < nt; t += 2) {
            const bool last = (t == nt - 2);
            const size_t k1 = (size_t)(t + 1) * kstep, k2 = last ? 0 : (size_t)(t + 2) * kstep, k3 = k2 + kstep;
            const char* a2 = last ? nA : cA; const char* b2 = (last ? nB : cB) + k2; const char* b3 = b2 + kstep;
            unsigned so[2][2];
#pragma unroll
            for (int h = 0; h < 2; ++h)
#pragma unroll
                for (int i = 0; i < 2; ++i) so[h][i] = last ? no[h][i] : co[h][i];
            if (last && has_next) S.a_ready(nxt);
            if constexpr (Epi::HAS_MID) { if (t == Epi::MID_T) E.mid(st, acc, cur, wr, wc, fr, fq); }
            PG8_LDB(B0, 0, 0); PG8_LDB(B1, 0, 1); PG8_SCHED; PG8_LDA(At, 0, 0); PG8_STAGE_A(PG8_SA(1, 1), cA, co, 1, k1);
            PG8_WAIT_V(8); PG8_WAIT_L(0); PG8_BAR; PG8_MMA(0, 0, At, B0); PG8_MMA(0, 1, At, B1); PG8_BAR; PG8_SCHED;
            PG8_LDA(At, 0, 1); PG8_STAGE(PG8_SB(0, 0), b2, voffB); PG8_STAGE(PG8_SB(0, 1), b2 + hstep, voffB); PG8_STAGE_A(PG8_SA(0, 0), a2, so, 0, k2);
            PG8_WAIT_V(8); PG8_WAIT_L(0); PG8_BAR; PG8_MMA(1, 0, At, B0); PG8_MMA(1, 1, At, B1); PG8_BAR; PG8_SCHED;
            PG8_LDB(B0, 1, 0); PG8_LDB(B1, 1, 1); PG8_SCHED; PG8_LDA(At, 1, 0); PG8_STAGE_A(PG8_SA(0, 1), a2, so, 1, k2);
            PG8_WAIT_V(8); PG8_WAIT_L(0); PG8_BAR; PG8_MMA(0, 0, At, B0); PG8_MMA(0, 1, At, B1); PG8_BAR; PG8_SCHED;
            PG8_LDA(At, 1, 1); PG8_STAGE(PG8_SB(1, 0), b3, voffB); PG8_STAGE(PG8_SB(1, 1), b3 + hstep, voffB); PG8_STAGE_A(PG8_SA(1, 0), a2, so, 0, k3);
            PG8_WAIT_V(8); PG8_WAIT_L(0); PG8_BAR; PG8_MMA(1, 0, At, B0); PG8_MMA(1, 1, At, B1); PG8_BAR; PG8_SCHED;
        }
        if constexpr (ALIGN_EPI) { if (wr == 0) PG8_BAR; }
        if constexpr (!Epi::AFTER_DRAIN) { E(st, acc, cur, wr, wc, fr, fq); S.done(cur); }
        if (!has_next) break;
#pragma unroll
        for (int a = 0; a < 2; ++a)
#pragma unroll
            for (int b = 0; b < 2; ++b)
#pragma unroll
                for (int m = 0; m < 4; ++m)
#pragma unroll
                    for (int n = 0; n < 2; ++n) acc[a][b][m][n] = (f32x4){0.f, 0.f, 0.f, 0.f};
        cur = nxt; cA = nA; cB = nB; ++ui;
#pragma unroll
        for (int h = 0; h < 2; ++h)
#pragma unroll
            for (int i = 0; i < 2; ++i) co[h][i] = no[h][i];
        if constexpr (ALIGN_EPI) { if (wr == 1) PG8_BAR; }
    }
    PG8_WAIT_V(0);
    if constexpr (!ALIGN_EPI) { if (wr == 0) PG8_BAR; }
    PG8_BAR;
    if constexpr (Epi::AFTER_DRAIN) { E.fused(st, acc, cur, wr, wc, fr, fq, lds, wid, lane); S.done(cur); }
#undef PG8_SA
#undef PG8_SB
#undef PG8_STAGE
#undef PG8_STAGE_A
#undef PG8_LDA
#undef PG8_LDB
#undef PG8_MMA
#undef PG8_WAIT_V
#undef PG8_WAIT_L
#undef PG8_BAR
#undef PG8_SCHED
#undef PG8_GOFF
}
}

#define LAS __attribute__((address_space(3)))
#define GAS __attribute__((address_space(1)))
#define XB_TMO      128
#define XB_XCNT(j)  (256  + 64 * (j))
#define XB_XSUB(j)  (1280 + 64 * (j))
#define XB_XGEN(j)  (2304 + 64 * (j))
#define XB_TOP      3328
#define XB_TOPGEN   3392
#define XCD_BAR_WORDS 3456
#define XB_SPIN_CAP (1u << 18)

__device__ __forceinline__ unsigned xb_ld(unsigned* p)              { return __hip_atomic_load(p, __ATOMIC_RELAXED, __HIP_MEMORY_SCOPE_AGENT); }
__device__ __forceinline__ unsigned xb_add(unsigned* p, unsigned v) { return __hip_atomic_fetch_add(p, v, __ATOMIC_RELAXED, __HIP_MEMORY_SCOPE_AGENT); }
__device__ __forceinline__ unsigned xb_xcc_id() { return (unsigned)__builtin_amdgcn_s_getreg((3 << 11) | 20) & 0xFu; }
#define XB_SPIN(cond, bar) do { unsigned _sp = 0; while (cond) { __builtin_amdgcn_s_sleep(1); \
    if ((++_sp & 255u) == 0u) { if (xb_ld(&(bar)[XB_TMO])) break; if (_sp > XB_SPIN_CAP) { atomicAdd(&(bar)[XB_TMO], 1u); break; } } } } while (0)

struct XcdBarrier {
    unsigned* bar; unsigned x;
    volatile LAS unsigned* st;
};

__device__ __forceinline__ XcdBarrier xcd_barrier_post(unsigned* bar, volatile LAS unsigned* st) {
    XcdBarrier b; b.bar = bar; b.x = xb_xcc_id(); b.st = st;
    if (threadIdx.x == 0) (void)xb_add(&bar[XB_XCNT(b.x)], 1u);
    return b;
}
__device__ __forceinline__ void xcd_barrier_complete(unsigned* bar, unsigned x, unsigned& nloc, unsigned& nx) {
    const unsigned G = gridDim.x * gridDim.y * gridDim.z;
    unsigned sum, cnt, mine, sp = 0u;
    for (;;) {
        sum = 0u; cnt = 0u; mine = 0u;
#pragma unroll
        for (unsigned j = 0; j < 16; ++j) { const unsigned c = xb_ld(&bar[XB_XCNT(j)]); sum += c; cnt += (c > 0u) ? 1u : 0u; mine = (j == x) ? c : mine; }
        if (sum == G) break;
        __builtin_amdgcn_s_sleep(1);
        if ((++sp & 255u) == 0u) { if (xb_ld(&bar[XB_TMO])) break; if (sp > XB_SPIN_CAP) { atomicAdd(&bar[XB_TMO], 1u); break; } }
    }
    nloc = mine > 0u ? mine : 1u; nx = cnt > 0u ? cnt : 1u;
}

__device__ __forceinline__ void xcd_barrier(const XcdBarrier& b) {
    asm volatile("s_waitcnt vmcnt(0)" ::: "memory");
    __syncthreads();
    if (threadIdx.x == 0) {
        unsigned* bar = b.bar;
        __builtin_amdgcn_s_waitcnt(0);
        unsigned nloc = b.st[0], nx = b.st[1];
        if (nloc == 0u) { xcd_barrier_complete(bar, b.x, nloc, nx); b.st[0] = nloc; b.st[1] = nx; }
        const unsigned old = xb_add(&bar[XB_XSUB(b.x)], 1u);
        const unsigned gen = old / nloc;
        if (old + 1u == (gen + 1u) * nloc) {
            __builtin_amdgcn_fence(__ATOMIC_RELEASE, "agent");
            asm volatile("s_waitcnt vmcnt(0)" ::: "memory");
            const unsigned og = xb_add(&bar[XB_TOP], 1u);
            const unsigned tg = og / nx;
            if (og + 1u == (tg + 1u) * nx) xb_add(&bar[XB_TOPGEN], 1u);
            else XB_SPIN(xb_ld(&bar[XB_TOPGEN]) == tg, bar);
            __builtin_amdgcn_fence(__ATOMIC_ACQUIRE, "agent");
            xb_add(&bar[XB_XGEN(b.x)], 1u);
            asm volatile("s_waitcnt vmcnt(0)" ::: "memory");
        } else {
            XB_SPIN(xb_ld(&bar[XB_XGEN(b.x)]) == gen, bar);
            __builtin_amdgcn_fence(__ATOMIC_ACQUIRE, "agent");
            asm volatile("s_waitcnt vmcnt(0)" ::: "memory");
        }
    }
    __syncthreads();
}

typedef unsigned short bf16;
typedef unsigned v4u __attribute__((ext_vector_type(4)));
typedef unsigned v2u __attribute__((ext_vector_type(2)));
typedef float f32x4 __attribute__((ext_vector_type(4)));
typedef float f32x2_t __attribute__((ext_vector_type(2)));
typedef __bf16 bf16x2_t __attribute__((ext_vector_type(2)));
typedef short bf16x8 __attribute__((ext_vector_type(8)));
typedef short s16x4 __attribute__((ext_vector_type(4)));
typedef float f32x16 __attribute__((ext_vector_type(16)));
#define LDS_WAIT() asm volatile("s_waitcnt lgkmcnt(0)" ::: "memory")
#define VM_WAIT() asm volatile("s_waitcnt vmcnt(0)" ::: "memory")
#define SBAR() __builtin_amdgcn_sched_barrier(0)
__device__ __forceinline__ unsigned pk2(float lo, float hi) { f32x2_t v = {lo, hi}; bf16x2_t b = __builtin_convertvector(v, bf16x2_t); return __builtin_bit_cast(unsigned, b); }
__device__ __forceinline__ float bf2f(unsigned short h) { return __builtin_bit_cast(float, (unsigned)h << 16); }
__device__ __forceinline__ float wave_sum(float v) {
#pragma unroll
    for (int o = 1; o < 64; o <<= 1) v += __shfl_xor(v, o);
    return v;
}
__device__ const float INV_FREQ[16] = {1.000000000e+00f, 5.623413324e-01f, 3.162277639e-01f, 1.778279394e-01f, 1.000000015e-01f, 5.623412877e-02f, 3.162277862e-02f, 1.778279431e-02f,
                                       9.999999776e-03f, 5.623413250e-03f, 3.162277862e-03f, 1.778279431e-03f, 1.000000047e-03f, 5.623413017e-04f, 3.162277862e-04f, 1.778279402e-04f};

static_assert((CW_BAR + XCD_BAR_WORDS) * 4 <= (int)CTL_ZERO_BYTES, "CTL words inside the memset region");
namespace att {
#define KSWZ(row, colB) ((row) * 256 + ((colB) ^ (((row) & 7) << 4)))
__device__ __forceinline__ int crow(int r, int hi) { return (r & 3) + 8 * (r >> 2) + 4 * hi; }
__device__ __forceinline__ unsigned cvtpk(float lo, float hi) { return pk2(lo, hi); }
__device__ __forceinline__ int v_st(int k, int c) { const int kk = (k & ~0xC) | ((k & 4) << 1) | ((k & 8) >> 1); return ((kk >> 3) * 2 + (c >> 5)) * 512 + ((kk & 7) * 32 + (c & 31)) * 2; }
__device__ __forceinline__ int v_rd_base(int lane) { return ((lane & 3) << 3) | (((lane >> 2) & 3) << 6) | (((lane >> 4) & 1) << 5) | (((lane >> 5) & 1) << 8); }
constexpr int v_rd_off(int d0, int ks, int half) { return d0 * 512 + ks * 2048 + half * 1024; }
template <int OFF> __device__ __forceinline__ s16x4 tr_read(int vb) {
  s16x4 r; asm volatile("ds_read_b64_tr_b16 %0, %1 offset:%2" : "=&v"(r) : "v"(vb), "i"(OFF) : "memory"); return r;
}
template <int D0> __device__ __forceinline__ void pv_one(f32x16& od, int vb, bf16x8 pa0, bf16x8 pa1, bf16x8 pa2, bf16x8 pa3) {
  const s16x4 l0 = tr_read<v_rd_off(D0, 0, 0)>(vb), h0 = tr_read<v_rd_off(D0, 0, 1)>(vb), l1 = tr_read<v_rd_off(D0, 1, 0)>(vb), h1 = tr_read<v_rd_off(D0, 1, 1)>(vb);
  const s16x4 l2 = tr_read<v_rd_off(D0, 2, 0)>(vb), h2 = tr_read<v_rd_off(D0, 2, 1)>(vb), l3 = tr_read<v_rd_off(D0, 3, 0)>(vb), h3 = tr_read<v_rd_off(D0, 3, 1)>(vb);
  asm volatile("s_waitcnt lgkmcnt(0)" ::: "memory"); SBAR();
#define PK(L, H) (bf16x8){L[0], L[1], L[2], L[3], H[0], H[1], H[2], H[3]}
  od = __builtin_amdgcn_mfma_f32_32x32x16_bf16(pa0, PK(l0, h0), od, 0, 0, 0);
  od = __builtin_amdgcn_mfma_f32_32x32x16_bf16(pa1, PK(l1, h1), od, 0, 0, 0);
  od = __builtin_amdgcn_mfma_f32_32x32x16_bf16(pa2, PK(l2, h2), od, 0, 0, 0);
  od = __builtin_amdgcn_mfma_f32_32x32x16_bf16(pa3, PK(l3, h3), od, 0, 0, 0);
#undef PK
}
__device__ __forceinline__ void pv_2(f32x16* o, int vb, bf16x8 pa0, bf16x8 pa1, bf16x8 pa2, bf16x8 pa3) {
  pv_one<0>(o[0], vb, pa0, pa1, pa2, pa3); pv_one<1>(o[1], vb, pa0, pa1, pa2, pa3);
}
__device__ __forceinline__ void pack_p(const f32x16& p0, const f32x16& p1, bf16x8& pa0, bf16x8& pa1, bf16x8& pa2, bf16x8& pa3) {
#define PK4(P, BASE, OUT) do { unsigned a0 = cvtpk(P[BASE + 0], P[BASE + 1]), a1 = cvtpk(P[BASE + 2], P[BASE + 3]);   \
    unsigned b0 = cvtpk(P[BASE + 4], P[BASE + 5]), b1 = cvtpk(P[BASE + 6], P[BASE + 7]);                              \
    auto r0 = __builtin_amdgcn_permlane32_swap(a0, b0, false, false); auto r1 = __builtin_amdgcn_permlane32_swap(a1, b1, false, false); \
    v4u w = {r0[0], r1[0], r0[1], r1[1]}; OUT = __builtin_bit_cast(bf16x8, w); } while (0)
  PK4(p0, 0, pa0); PK4(p0, 8, pa1); PK4(p1, 0, pa2); PK4(p1, 8, pa3);
#undef PK4
}

namespace mla {
constexpr int NW = 8, QBLK = 32, KVBLK = 64;
constexpr float SCALE = 0.10206207261596575f;
constexpr float THR = 8.f;
constexpr int SHM_V = 8192, SHM_K = 16384, SHM_TOTAL = 2 * SHM_V + 2 * SHM_K + NW * 64 * 4;
__device__ __forceinline__ void partialSM(f32x16& p0, f32x16& p1, float& m_reg, float& mn, float& alpha) {
  constexpr float C = SCALE * LOG2E;
  float pmax = p0[0];
#pragma unroll
  for (int r = 1; r < 16; ++r) pmax = fmaxf(pmax, p0[r]);
#pragma unroll
  for (int r = 0; r < 16; ++r) pmax = fmaxf(pmax, p1[r]);
  { auto rr = __builtin_amdgcn_permlane32_swap(__float_as_uint(pmax), __float_as_uint(pmax), false, false);
    pmax = fmaxf(__uint_as_float(rr[0]), __uint_as_float(rr[1])); }
  if (__builtin_expect(__all(pmax - m_reg <= THR / SCALE), 1)) { mn = m_reg; alpha = 1.f; }
  else { mn = fmaxf(m_reg, pmax); alpha = __builtin_amdgcn_exp2f((m_reg - mn) * C); m_reg = mn; }
  const float mnC = -mn * C;
#pragma unroll
  for (int r = 0; r < 16; ++r) p0[r] = fmaf(p0[r], C, mnC);
#pragma unroll
  for (int r = 0; r < 16; ++r) p1[r] = fmaf(p1[r], C, mnC);
#pragma unroll
  for (int r = 0; r < 16; ++r) p0[r] = __builtin_amdgcn_exp2f(p0[r]);
}
__device__ __forceinline__ void finishSM(f32x16& p0, f32x16& p1, float alpha, float& l_reg, bf16x8& pa0, bf16x8& pa1, bf16x8& pa2, bf16x8& pa3) {
#pragma unroll
  for (int r = 0; r < 16; ++r) p1[r] = __builtin_amdgcn_exp2f(p1[r]);
  float ps = 0;
#pragma unroll
  for (int r = 0; r < 16; ++r) ps += p0[r];
#pragma unroll
  for (int r = 0; r < 16; ++r) ps += p1[r];
  { auto rr = __builtin_amdgcn_permlane32_swap(__float_as_uint(ps), __float_as_uint(ps), false, false);
    ps = __uint_as_float(rr[0]) + __uint_as_float(rr[1]); }
  l_reg = l_reg * alpha + ps;
  pack_p(p0, p1, pa0, pa1, pa2, pa3);
}
__device__ __forceinline__ void qkt(f32x16& p0, f32x16& p1, const char* Ks, const bf16x8* qr, int r32, int hi) {
  p0 = f32x16{}; p1 = f32x16{};
#pragma unroll
  for (int d0 = 0; d0 < 6; ++d0) { const int cb = (d0 * 16 + hi * 8) * 2;
    const bf16x8 b0 = *reinterpret_cast<const bf16x8*>(Ks + KSWZ(r32, cb));
    const bf16x8 b1 = *reinterpret_cast<const bf16x8*>(Ks + KSWZ(32 + r32, cb));
    p0 = __builtin_amdgcn_mfma_f32_32x32x16_bf16(b0, qr[d0], p0, 0, 0, 0);
    p1 = __builtin_amdgcn_mfma_f32_32x32x16_bf16(b1, qr[d0], p1, 0, 0, 0); }
}
__device__ __forceinline__ void unit(int b, int h, int qb, const bf16* __restrict__ QB, const bf16* __restrict__ KVB, const bf16* __restrict__ KR,
                                     const float* __restrict__ COS, const float* __restrict__ SIN, bf16* __restrict__ Y, char* lds) {
  int tid_ = threadIdx.x; asm volatile("" : "+v"(tid_));
  const int tid = tid_, wid = tid >> 6, lane = tid & 63, r32 = lane & 31, hi = lane >> 5;
  char* V_lds = lds; char* K_lds = lds + 2 * SHM_V;
  float* ws = (float*)(lds + 2 * SHM_V + 2 * SHM_K) + wid * 64; float* li_l = ws; float* al_l = ws + 32;
  float m_reg = -1e30f, l_reg = 0; f32x16 o[2] = {}; bf16x8 qr[6];
  const size_t tokq = (size_t)b * SEQ + qb * 256 + wid * QBLK + r32;
  { const bf16* Qw = QB + tokq * 768 + h * 96 + hi * 8;
#pragma unroll
    for (int d0 = 0; d0 < 6; ++d0) qr[d0] = *reinterpret_cast<const bf16x8*>(Qw + d0 * 16);
    const f32x4 c0 = *(const f32x4*)(COS + tokq * 16 + hi * 8), c1 = *(const f32x4*)(COS + tokq * 16 + hi * 8 + 4);
    const f32x4 s0 = *(const f32x4*)(SIN + tokq * 16 + hi * 8), s1 = *(const f32x4*)(SIN + tokq * 16 + hi * 8 + 4);
    float o1[8], o2[8];
#pragma unroll
    for (int j = 0; j < 8; ++j) { const float t1 = bf2f((unsigned short)qr[4][j]), t2 = bf2f((unsigned short)qr[5][j]); const float c = j < 4 ? c0[j & 3] : c1[j & 3], s = j < 4 ? s0[j & 3] : s1[j & 3];
      o1[j] = t1 * c - t2 * s; o2[j] = t1 * s + t2 * c; }
    v4u w1 = {pk2(o1[0], o1[1]), pk2(o1[2], o1[3]), pk2(o1[4], o1[5]), pk2(o1[6], o1[7])}, w2 = {pk2(o2[0], o2[1]), pk2(o2[2], o2[3]), pk2(o2[4], o2[5]), pk2(o2[6], o2[7])};
    qr[4] = __builtin_bit_cast(bf16x8, w1); qr[5] = __builtin_bit_cast(bf16x8, w2); }
  const int ksr = tid >> 4, kcc = tid & 15, kc = kcc < 12 ? kcc : kcc - 4;
  const bf16* kbase = kc < 8 ? KVB + ((size_t)b * SEQ + ksr) * 1024 + h * 128 + kc * 8 : KR + ((size_t)b * SEQ + ksr) * 32 + (kc - 8) * 8;
  const int kstr = kc < 8 ? 1024 : 32;
  const int vrow = tid >> 3, vcc = tid & 7;
  const bf16* vbase = KVB + ((size_t)b * SEQ + vrow) * 1024 + h * 128 + 64 + vcc * 8;
  const int kst0 = KSWZ(ksr, kc * 16), kst1 = KSWZ(32 + ksr, kc * 16), vst = v_st(vrow, vcc * 8);
  const int vb0 = (int)(uintptr_t)V_lds + v_rd_base(lane);
  struct { bf16x8 vs, ks0, ks1; } sr_[2];
#define SLOAD(i, k0) do { sr_[i].vs = *reinterpret_cast<const bf16x8*>(vbase + (size_t)(k0) * 1024); \
    sr_[i].ks0 = *reinterpret_cast<const bf16x8*>(kbase + (size_t)(k0) * kstr); sr_[i].ks1 = *reinterpret_cast<const bf16x8*>(kbase + (size_t)((k0) + 32) * kstr); } while (0)
#define SWRITE(bb, i) do { *(bf16x8*)(V_lds + (bb) * SHM_V + vst) = sr_[i].vs; *(bf16x8*)(K_lds + (bb) * SHM_K + kst0) = sr_[i].ks0; *(bf16x8*)(K_lds + (bb) * SHM_K + kst1) = sr_[i].ks1; } while (0)
#define SWAIT() asm volatile("s_waitcnt vmcnt(3)" ::: "memory")
#define RESC(a) do { if (__any((a) < 1.f)) { if (hi == 0) al_l[r32] = (a); asm volatile("s_waitcnt lgkmcnt(0)" ::: "memory"); \
    _Pragma("unroll") for (int d = 0; d < 2; ++d) _Pragma("unroll") for (int r = 0; r < 16; ++r) o[d][r] *= al_l[crow(r, hi)]; } } while (0)
  f32x16 pA0, pA1, pB0, pB1; float mnA, mnB, alA, alB; bf16x8 pa0, pa1, pa2, pa3; constexpr int NT = SEQ / KVBLK;
  constexpr int SE = 0, SO = 1;
  SLOAD(SE, 0); asm volatile("s_waitcnt vmcnt(0)" ::: "memory"); SWRITE(0, SE); __syncthreads();
  qkt(pA0, pA1, K_lds, qr, r32, hi); partialSM(pA0, pA1, m_reg, mnA, alA);
  SLOAD(SO, KVBLK); SLOAD(SE, 2 * KVBLK);
  SWAIT(); SWRITE(1, SO); __syncthreads();
  for (int j = 1; j + 1 < NT; j += 2) {
    SBAR(); qkt(pB0, pB1, K_lds + SHM_K, qr, r32, hi);
    finishSM(pA0, pA1, alA, l_reg, pa0, pa1, pa2, pa3); SBAR();
    SLOAD(SO, (j + 2) * KVBLK); SBAR();
    pv_2(o, vb0, pa0, pa1, pa2, pa3); partialSM(pB0, pB1, m_reg, mnB, alB);
    __syncthreads(); SWAIT(); SWRITE(0, SE);
    RESC(alB); __syncthreads();
    SBAR(); qkt(pA0, pA1, K_lds, qr, r32, hi);
    finishSM(pB0, pB1, alB, l_reg, pa0, pa1, pa2, pa3); SBAR();
    if (j + 3 < NT) SLOAD(SE, (j + 3) * KVBLK); SBAR();
    pv_2(o, vb0 + SHM_V, pa0, pa1, pa2, pa3); partialSM(pA0, pA1, m_reg, mnA, alA);
    __syncthreads(); SWAIT(); SWRITE(1, SO);
    RESC(alA); __syncthreads();
  }
  SBAR(); qkt(pB0, pB1, K_lds + SHM_K, qr, r32, hi);
  finishSM(pA0, pA1, alA, l_reg, pa0, pa1, pa2, pa3); SBAR();
  pv_2(o, vb0, pa0, pa1, pa2, pa3); partialSM(pB0, pB1, m_reg, mnB, alB);
  __syncthreads(); RESC(alB);
  finishSM(pB0, pB1, alB, l_reg, pa0, pa1, pa2, pa3); SBAR();
  pv_2(o, vb0 + SHM_V, pa0, pa1, pa2, pa3);
  if (hi == 0) li_l[r32] = l_reg; asm volatile("s_waitcnt lgkmcnt(0)" ::: "memory");
  float rli[16];
#pragma unroll
  for (int r = 0; r < 16; ++r) rli[r] = __builtin_amdgcn_rcpf(li_l[crow(r, hi)]);
  bf16* Ow = Y + ((size_t)b * SEQ + qb * 256 + wid * QBLK) * 1024 + 512 + h * 64;
#pragma unroll
  for (int r = 0; r < 16; ++r) { const int orow = crow(r, hi);
#pragma unroll
    for (int d0 = 0; d0 < 2; ++d0) Ow[(size_t)orow * 1024 + d0 * 32 + r32] = (bf16)(pk2(o[d0][r] * rli[r], 0.f) & 0xffffu); }
  __syncthreads();
#undef SLOAD
#undef SWRITE
#undef SWAIT
#undef RESC
}
}

namespace wnd {
constexpr int LDS_V = 0, LDS_K = 8192, LDS_TAB = 8192 + 16384, LDS_WS = LDS_TAB + 2048, LDS_TOTAL = LDS_WS + 8 * 256;
__device__ __forceinline__ int t5_bucket(int rel) {
  const int n = rel < 0 ? -rel : rel; int bk;
  if (n < 8) bk = n; else bk = 8 + (n > 11) + (n > 15) + (n > 22) + (n > 31) + (n > 45) + (n > 63) + (n > 90);
  return (rel > 0 ? 16 : 0) + bk;
}
__device__ __forceinline__ void unit(int b, int h, int qb, const bf16* __restrict__ QA, const bf16* __restrict__ KVA, const float* __restrict__ rel_bias, const float* __restrict__ sink,
                                     bf16* __restrict__ Y, char* lds) {
  int tid_ = threadIdx.x; asm volatile("" : "+v"(tid_));
  const int tid = tid_, wid = tid >> 6, lane = tid & 63, r32 = lane & 31, hi = lane >> 5, kvh = h >> 2;
  char* V_lds = lds + LDS_V; char* K_lds = lds + LDS_K; float* tab = (float*)(lds + LDS_TAB); float* al_l = (float*)(lds + LDS_WS) + wid * 64; float* li_l = al_l + 32;
  for (int i = tid; i < 385; i += 512) { const int rel = i - 192, n = rel < 0 ? -rel : rel; tab[i] = n <= 128 ? rel_bias[t5_bucket(rel) * 8 + h] * LOG2E : -1e30f; }
  const int q0 = qb * 256;
  bf16x8 qr[4];
  { const bf16* Qw = QA + ((size_t)b * SEQ + q0 + wid * 32 + r32) * 512 + h * 64 + hi * 8;
#pragma unroll
    for (int d0 = 0; d0 < 4; ++d0) qr[d0] = *reinterpret_cast<const bf16x8*>(Qw + d0 * 16); }
  float m_reg = sink[h] * LOG2E, l_reg = 1.0f; f32x16 o[2] = {};
  const int srow = tid >> 3, scc = tid & 7;
  const bf16* kbase = KVA + (size_t)b * SEQ * 256 + kvh * 64 + scc * 8; const bf16* vbase = kbase + 128;
  const int kst = KSWZ(srow, scc * 16), vst = v_st(srow, scc * 8);
  const int vb0 = (int)(uintptr_t)V_lds + v_rd_base(lane);
  constexpr float C = 0.125f * LOG2E;
  const int t_lo = qb == 0 ? 2 : 0, t_hi = qb == SEQ / 256 - 1 ? 6 : 8, wlo = wid >> 1;
  for (int t = t_lo; t < t_hi; ++t) {
    const int k0 = q0 - 128 + 64 * t;
    const bf16x8 kreg = *reinterpret_cast<const bf16x8*>(kbase + (size_t)(k0 + srow) * 256), vreg = *reinterpret_cast<const bf16x8*>(vbase + (size_t)(k0 + srow) * 256);
    __syncthreads();
    *(bf16x8*)(K_lds + kst) = kreg; *(bf16x8*)(V_lds + vst) = vreg;
    __syncthreads();
    if (t >= wlo && t <= wlo + 4) {
      f32x16 p0 = {}, p1 = {};
#pragma unroll
      for (int d0 = 0; d0 < 4; ++d0) { const int cb = (d0 * 16 + hi * 8) * 2;
        const bf16x8 b0 = *reinterpret_cast<const bf16x8*>(K_lds + KSWZ(r32, cb)), b1 = *reinterpret_cast<const bf16x8*>(K_lds + KSWZ(32 + r32, cb));
        p0 = __builtin_amdgcn_mfma_f32_32x32x16_bf16(b0, qr[d0], p0, 0, 0, 0); p1 = __builtin_amdgcn_mfma_f32_32x32x16_bf16(b1, qr[d0], p1, 0, 0, 0); }
      const int base = k0 - (q0 + wid * 32 + r32) + 192 + 4 * hi;
#pragma unroll
      for (int r = 0; r < 16; ++r) { const int i0 = base + (r & 3) + 8 * (r >> 2); p0[r] = fmaf(p0[r], C, tab[i0]); p1[r] = fmaf(p1[r], C, tab[i0 + 32]); }
      float pmax = p0[0];
#pragma unroll
      for (int r = 1; r < 16; ++r) pmax = fmaxf(pmax, p0[r]);
#pragma unroll
      for (int r = 0; r < 16; ++r) pmax = fmaxf(pmax, p1[r]);
      { auto rr = __builtin_amdgcn_permlane32_swap(__float_as_uint(pmax), __float_as_uint(pmax), false, false); pmax = fmaxf(__uint_as_float(rr[0]), __uint_as_float(rr[1])); }
      const float mn = fmaxf(m_reg, pmax), alpha = __builtin_amdgcn_exp2f(m_reg - mn); m_reg = mn;
      float ps = 0.f;
#pragma unroll
      for (int r = 0; r < 16; ++r) { p0[r] = __builtin_amdgcn_exp2f(p0[r] - mn); p1[r] = __builtin_amdgcn_exp2f(p1[r] - mn); ps += p0[r] + p1[r]; }
      { auto rr = __builtin_amdgcn_permlane32_swap(__float_as_uint(ps), __float_as_uint(ps), false, false); ps = __uint_as_float(rr[0]) + __uint_as_float(rr[1]); }
      l_reg = l_reg * alpha + ps;
      if (__any(alpha < 1.f)) { if (hi == 0) al_l[r32] = alpha; asm volatile("s_waitcnt lgkmcnt(0)" ::: "memory");
#pragma unroll
        for (int d = 0; d < 2; ++d)
#pragma unroll
          for (int r = 0; r < 16; ++r) o[d][r] *= al_l[crow(r, hi)]; }
      bf16x8 pa0, pa1, pa2, pa3; pack_p(p0, p1, pa0, pa1, pa2, pa3);
      SBAR(); pv_2(o, vb0, pa0, pa1, pa2, pa3);
    }
  }
  if (hi == 0) li_l[r32] = l_reg; asm volatile("s_waitcnt lgkmcnt(0)" ::: "memory");
  float rli[16];
#pragma unroll
  for (int r = 0; r < 16; ++r) rli[r] = __builtin_amdgcn_rcpf(li_l[crow(r, hi)]);
  bf16* Ow = Y + ((size_t)b * SEQ + q0 + wid * 32) * 1024 + h * 64;
#pragma unroll
  for (int r = 0; r < 16; ++r) { const int orow = crow(r, hi);
#pragma unroll
    for (int d0 = 0; d0 < 2; ++d0) Ow[(size_t)orow * 1024 + d0 * 32 + r32] = (bf16)(pk2(o[d0][r] * rli[r], 0.f) & 0xffffu); }
  __syncthreads();
}
}
#undef KSWZ
}

struct Frame {
    char* lds; int tid, lane, wave, vcu, G, gw, NGW;
    unsigned char* ws;
};

__device__ __forceinline__ void transpose_item(const float* __restrict__ W, int N, int k0, int n0, bf16* dst  , int ldk, float* scr, int lane) {
#pragma unroll 8
    for (int i = 0; i < 32; ++i) { const int kk = 2 * i + (lane >> 5); scr[kk * 33 + (lane & 31)] = W[(size_t)(k0 + kk) * N + n0 + (lane & 31)]; }
    LDS_WAIT(); asm volatile("" ::: "memory");
    const int c = lane & 7;
#pragma unroll
    for (int j = 0; j < 4; ++j) { const int n = (lane >> 3) + 8 * j; const float* s = scr + (8 * c) * 33 + n;
        v4u o; o.x = pk2(s[0 * 33], s[1 * 33]); o.y = pk2(s[2 * 33], s[3 * 33]); o.z = pk2(s[4 * 33], s[5 * 33]); o.w = pk2(s[6 * 33], s[7 * 33]);
        *(v4u*)(dst + (size_t)n * ldk + k0 + 8 * c) = o; }
    LDS_WAIT(); asm volatile("" ::: "memory");
}

__device__ __forceinline__ void p0_prologue(const Frame& F) {
    int tid = threadIdx.x; asm volatile("" : "+v"(tid)); const int lane = tid & 63;
    const KArgs ka = kargs();
    float* scr = (float*)(F.lds + F.wave * 16384);
    unsigned char* ws = F.ws;
    const float* w_in = (const float*)ka->in[5]; const float* w_uq = (const float*)ka->in[9]; const float* w_ukv = (const float*)ka->in[10];
    constexpr int I_IN = 16 * 37, I_UQ = 4 * 24, I_UKV = 2 * 32;
    constexpr int NITEMS = I_IN + I_UQ + I_UKV;
    for (int it = F.gw; it < NITEMS; it += F.NGW) {
        int r = it;
        if (r < I_IN) { const int kb = r / 37, nb = r % 37; transpose_item(w_in, IN_COLS, 64 * kb, 32 * nb, (bf16*)(ws + WS_WIN) + (size_t)(32 * nb) * 1024, 1024, scr, lane); continue; } r -= I_IN;
        if (r < I_UQ) { const int kb = r / 24, nb = r % 24; transpose_item(w_uq, 768, 64 * kb, 32 * nb, (bf16*)(ws + WS_WUQ) + (size_t)(32 * nb) * 256, 256, scr, lane); continue; } r -= I_UQ;
        { const int kb = r / 32, nb = r % 32; transpose_item(w_ukv, 1024, 64 * kb, 32 * nb, (bf16*)(ws + WS_WUKV) + (size_t)(32 * nb) * 256, 256, scr, lane); }
    }
    const int gt = F.vcu * 512 + tid, NGT = F.G * 512;
    for (int i = gt; i < 96 * 128; i += NGT) ((v4u*)((bf16*)(ws + WS_WIN) + (size_t)IN_COLS * 1024))[i] = (v4u){0u, 0u, 0u, 0u};
    for (int i = gt; i < 1024 * 16; i += NGT) *(v4u*)((bf16*)(ws + WS_WUKV) + (size_t)(i >> 4) * 256 + 128 + (i & 15) * 8) = (v4u){0u, 0u, 0u, 0u};
    const int* positions = (const int*)ka->in[2];
    for (int i = gt; i < T * 16; i += NGT) {
        const float ang = (float)positions[i >> 4] * INV_FREQ[i & 15];
        const double x = (double)ang, q = __builtin_rint(x * 0.63661977236758134308);
        const double r = (x - q * 1.5707963267948966192) - q * 6.123233995736766036e-17, r2 = r * r;
        const double sn = r * (1.0 + r2 * (-1.0 / 6 + r2 * (1.0 / 120 + r2 * (-1.0 / 5040 + r2 * (1.0 / 362880 + r2 * (-1.0 / 39916800 + r2 * (1.0 / 6227020800.0)))))));
        const double cs = 1.0 + r2 * (-0.5 + r2 * (1.0 / 24 + r2 * (-1.0 / 720 + r2 * (1.0 / 40320 + r2 * (-1.0 / 3628800 + r2 * (1.0 / 479001600.0 + r2 * (-1.0 / 87178291200.0)))))));
        const int qi = (int)((long long)q & 3);
        const double c_ = (qi == 0) ? cs : (qi == 1) ? -sn : (qi == 2) ? -cs : sn, s_ = (qi == 0) ? sn : (qi == 1) ? cs : (qi == 2) ? -sn : -cs;
        ((float*)(ws + WS_COS))[i] = (float)c_; ((float*)(ws + WS_SIN))[i] = (float)s_;
    }
    const float* x = (const float*)ka->in[0]; const float* g = (const float*)ka->in[4]; bf16* H = (bf16*)(ws + WS_HB);
    for (int m = F.gw; m < T; m += F.NGW) {
        const f32x4* xr = (const f32x4*)(x + (size_t)m * DM) + lane; f32x4 v[4]; float s = 0.f;
#pragma unroll
        for (int j = 0; j < 4; ++j) { v[j] = xr[64 * j]; s += (v[j].x * v[j].x + v[j].y * v[j].y) + (v[j].z * v[j].z + v[j].w * v[j].w); }
        const float rstd = 1.0f / sqrtf(wave_sum(s) * (1.0f / DM) + EPS);
        unsigned long long* o8 = (unsigned long long*)(H + (size_t)m * DM) + lane;
#pragma unroll
        for (int j = 0; j < 4; ++j) { const f32x4 gg = ((const f32x4*)g)[lane + 64 * j];
            o8[64 * j] = (unsigned long long)pk2(v[j].x * rstd * gg.x, v[j].y * rstd * gg.y) | ((unsigned long long)pk2(v[j].z * rstd * gg.z, v[j].w * rstd * gg.w) << 32); }
    }
}

__device__ __forceinline__ void convert_late_weights(const Frame& F, int widx, int nw) {
    int lane_ = threadIdx.x & 63; asm volatile("" : "+v"(lane_));
    const KArgs ka = kargs(); unsigned char* ws = F.ws; float* scr = (float*)(F.lds + F.wave * 16384);
    const float* w_out = (const float*)ka->in[13]; const float* w_eg = (const float*)ka->in[16]; const float* w_eu = (const float*)ka->in[17]; const float* w_ed = (const float*)ka->in[18];
    const float* w_pg = (const float*)ka->in[20]; const float* w_pp = (const float*)ka->in[21];
    constexpr int I_OUT = 16 * 32, I_G = 16 * 16 * 16, I_D = 16 * 8 * 32, I_PG = 16 * 32, I_PP = 4 * 32;
    constexpr int NITEMS = I_OUT + 2 * I_G + I_D + I_PG + I_PP;
    for (int it = widx; it < NITEMS; it += nw) {
        int r = it;
        if (r < I_OUT) { const int kb = r / 32, nb = r % 32; transpose_item(w_out, 1024, 64 * kb, 32 * nb, (bf16*)(ws + WS_WOUT) + (size_t)(32 * nb) * 1024, 1024, scr, lane_); continue; } r -= I_OUT;
        if (r < 2 * I_G) { const int up = r >= I_G; if (up) r -= I_G; const int e = r / 256, q = r % 256, kb = q / 16, nb = q % 16, n0 = 32 * nb;
            const size_t drow = (size_t)e * 1024 + 256 * (n0 / 128) + (n0 % 128) + (up ? 128 : 0);
            transpose_item((up ? w_eu : w_eg) + (size_t)e * 1024 * 512, 512, 64 * kb, n0, (bf16*)(ws + WS_WGU) + drow * 1024, 1024, scr, lane_); continue; } r -= 2 * I_G;
        if (r < I_D) { const int e = r / 256, q = r % 256, kb = q / 32, nb = q % 32;
            transpose_item(w_ed + (size_t)e * 512 * 1024, 1024, 64 * kb, 32 * nb, (bf16*)(ws + WS_WD) + ((size_t)e * 1024 + 32 * nb) * 512, 512, scr, lane_); continue; } r -= I_D;
        if (r < I_PG) { const int kb = r / 32, nb = r % 32; transpose_item(w_pg, 1024, 64 * kb, 32 * nb, (bf16*)(ws + WS_WPG) + (size_t)(32 * nb) * 1024, 1024, scr, lane_); continue; } r -= I_PG;
        { const int kb = r / 32, nb = r % 32; transpose_item(w_pp, 1024, 64 * kb, 32 * nb, (bf16*)(ws + WS_WPP) + (size_t)(32 * nb) * 256, 256, scr, lane_); }
    }
}

__device__ __forceinline__ void p5_group_norm(const Frame& F) {
    int tid = threadIdx.x; asm volatile("" : "+v"(tid)); const int lane = tid & 63;
    const KArgs ka = kargs();
    bf16* Y = (bf16*)(F.ws + WS_Y); const float* ga = (const float*)ka->in[11]; const float* gb = (const float*)ka->in[12];
    for (int m = F.gw; m < T; m += F.NGW) {
        v4u* yr = (v4u*)(Y + (size_t)m * 1024) + lane;
#pragma unroll
        for (int half = 0; half < 2; ++half) { const v4u w = yr[64 * half]; float f[8];
            f[0] = bf2f(w.x & 0xffff); f[1] = bf2f(w.x >> 16); f[2] = bf2f(w.y & 0xffff); f[3] = bf2f(w.y >> 16); f[4] = bf2f(w.z & 0xffff); f[5] = bf2f(w.z >> 16); f[6] = bf2f(w.w & 0xffff); f[7] = bf2f(w.w >> 16);
            float s = 0.f;
#pragma unroll
            for (int j = 0; j < 8; ++j) s += f[j] * f[j];
            const float rstd = 1.0f / sqrtf(wave_sum(s) * (1.0f / 512) + EPS);
            const float* g = (half ? gb : ga) + 8 * lane; const f32x4 g0 = *(const f32x4*)g, g1 = *(const f32x4*)(g + 4);
            v4u o; o.x = pk2(f[0] * rstd * g0.x, f[1] * rstd * g0.y); o.y = pk2(f[2] * rstd * g0.z, f[3] * rstd * g0.w); o.z = pk2(f[4] * rstd * g1.x, f[5] * rstd * g1.y); o.w = pk2(f[6] * rstd * g1.z, f[7] * rstd * g1.w);
            yr[64 * half] = o; }
    }
}

__device__ __forceinline__ void p7_ffn_norm_router(const Frame& F) {
    int tid = threadIdx.x; asm volatile("" : "+v"(tid)); const int lane = tid & 63;
    const KArgs ka = kargs();
    const float* x1 = ka->out; const float* g = (const float*)ka->in[14]; const float* w_router = (const float*)ka->in[15]; bf16* H = (bf16*)(F.ws + WS_HB); float* AFF = (float*)(F.ws + WS_AFF);
    f32x4* W4 = (f32x4*)F.lds;
    for (int idx = tid; idx < 16 * 4 * 64; idx += 512) { const int l = idx & 63, i = (idx >> 6) & 3, e = idx >> 8; f32x4 w;
#pragma unroll
        for (int j = 0; j < 4; ++j) w[j] = w_router[(size_t)(4 * l + 256 * j + i) * 16 + e];
        W4[idx] = w; }
    __syncthreads();
    for (int m = F.gw; m < T; m += F.NGW) {
        const f32x4* xr = (const f32x4*)(x1 + (size_t)m * DM) + lane; f32x4 v[4]; float s = 0.f;
#pragma unroll
        for (int j = 0; j < 4; ++j) { v[j] = xr[64 * j]; s += (v[j].x * v[j].x + v[j].y * v[j].y) + (v[j].z * v[j].z + v[j].w * v[j].w); }
        const float rstd = 1.0f / sqrtf(wave_sum(s) * (1.0f / DM) + EPS);
        unsigned long long* o8 = (unsigned long long*)(H + (size_t)m * DM) + lane;
#pragma unroll
        for (int j = 0; j < 4; ++j) { const f32x4 gg = ((const f32x4*)g)[lane + 64 * j]; v[j] = v[j] * rstd * gg;
            o8[64 * j] = (unsigned long long)pk2(v[j].x, v[j].y) | ((unsigned long long)pk2(v[j].z, v[j].w) << 32); }
        float lg[16];
#pragma unroll
        for (int e = 0; e < 16; ++e) { float acc = 0.f;
#pragma unroll
            for (int i = 0; i < 4; ++i) { const f32x4 w = W4[(e * 4 + i) * 64 + lane]; acc += v[0][i] * w[0] + v[1][i] * w[1] + v[2][i] * w[2] + v[3][i] * w[3]; }
            lg[e] = wave_sum(acc); asm volatile("" ::: "memory"); }
        float mx = lg[0];
#pragma unroll
        for (int e = 1; e < 16; ++e) mx = fmaxf(mx, lg[e]);
        float den = 0.f;
#pragma unroll
        for (int e = 0; e < 16; ++e) { lg[e] = __expf(lg[e] - mx); den += lg[e]; }
        const float rden = 1.0f / den; float mine = 0.f;
#pragma unroll
        for (int e = 0; e < 16; ++e) mine = (lane == e) ? lg[e] * rden : mine;
        if (lane < 16) AFF[((size_t)(m >> 11) * 16 + lane) * SEQ + (m & (SEQ - 1))] = mine;
    }
    __syncthreads();
}

__device__ __forceinline__ void p8_topk_gather(const Frame& F) {
    int tid = threadIdx.x; asm volatile("" : "+v"(tid)); const int lane = tid & 63;
    unsigned char* ws = F.ws; const float* AFF = (const float*)(ws + WS_AFF); int* INV = (int*)(ws + WS_INV); int* SEL = (int*)(ws + WS_SEL); float* VAL = (float*)(ws + WS_VAL);
    unsigned long long* keys = (unsigned long long*)F.lds;
    for (int task = F.vcu; task < NBE; task += F.G) {
        const int b = task >> 4, e = task & 15;
        for (int i = tid; i < SEQ; i += 512) keys[i] = ((unsigned long long)__float_as_uint(AFF[(size_t)task * SEQ + i]) << 32) | (unsigned)(SEQ - 1 - i);
        __syncthreads();
        for (int k = 2; k <= SEQ; k <<= 1)
            for (int j = k >> 1; j > 0; j >>= 1) {
                for (int p = tid; p < SEQ / 2; p += 512) { const int i = ((p & ~(j - 1)) << 1) | (p & (j - 1)), l = i | j; const bool desc = (i & k) == 0;
                    const unsigned long long x = keys[i], y = keys[l]; if ((x < y) == desc) { keys[i] = y; keys[l] = x; } }
                __syncthreads();
            }
        for (int c = tid; c < SEQ; c += 512) { const unsigned long long kk = keys[c]; const int idx = SEQ - 1 - (int)(unsigned)(kk & 0xffffffffu);
            if (c < CAP) { SEL[task * CAP + c] = idx; VAL[task * CAP + c] = __uint_as_float((unsigned)(kk >> 32)); INV[((size_t)b * SEQ + idx) * 16 + e] = c; }
            else INV[((size_t)b * SEQ + idx) * 16 + e] = -1; }
        __syncthreads();
    }
}

__device__ __forceinline__ void p11_combine_norm(const Frame& F) {
    int tid = threadIdx.x; asm volatile("" : "+v"(tid)); const int lane = tid & 63;
    const KArgs ka = kargs();
    unsigned char* ws = F.ws; float* xo = ka->out; const int* INV = (const int*)(ws + WS_INV); const bf16* OB = (const bf16*)(ws + WS_OB); bf16* H = (bf16*)(ws + WS_HB);
    const float* g = (const float*)ka->in[19]; const float* p = (const float*)ka->in[1]; bf16* PB = (bf16*)(ws + WS_PB);
    for (int m = F.gw; m < T; m += F.NGW) {
        f32x4* xr = (f32x4*)(xo + (size_t)m * DM) + lane; f32x4 v[4];
#pragma unroll
        for (int j = 0; j < 4; ++j) v[j] = xr[64 * j];
        const int inv = INV[(size_t)m * 16 + (lane & 15)]; const int b = m >> 11;
        for (int e = 0; e < 16; ++e) { const int c = __builtin_amdgcn_readlane(inv, e);
            if (c >= 0) { const v2u* orow = (const v2u*)(OB + ((size_t)(b * 16 + e) * CAP + c) * DM) + lane;
#pragma unroll
                for (int j = 0; j < 4; ++j) { const v2u w = orow[64 * j]; v[j].x += bf2f(w.x & 0xffff); v[j].y += bf2f(w.x >> 16); v[j].z += bf2f(w.y & 0xffff); v[j].w += bf2f(w.y >> 16); } } }
        float s = 0.f;
#pragma unroll
        for (int j = 0; j < 4; ++j) { xr[64 * j] = v[j]; s += (v[j].x * v[j].x + v[j].y * v[j].y) + (v[j].z * v[j].z + v[j].w * v[j].w); }
        const float rstd = 1.0f / sqrtf(wave_sum(s) * (1.0f / DM) + EPS);
        unsigned long long* o8 = (unsigned long long*)(H + (size_t)m * DM) + lane;
#pragma unroll
        for (int j = 0; j < 4; ++j) { const f32x4 gg = ((const f32x4*)g)[lane + 64 * j];
            o8[64 * j] = (unsigned long long)pk2(v[j].x * rstd * gg.x, v[j].y * rstd * gg.y) | ((unsigned long long)pk2(v[j].z * rstd * gg.z, v[j].w * rstd * gg.w) << 32); }
        const f32x4 pv = ((const f32x4*)(p + (size_t)m * PLE))[lane];
        ((unsigned long long*)(PB + (size_t)m * PLE))[lane] = (unsigned long long)pk2(pv.x, pv.y) | ((unsigned long long)pk2(pv.z, pv.w) << 32);
    }
}

__device__ __forceinline__ void p13_final_norm(const Frame& F) {
    int tid = threadIdx.x; asm volatile("" : "+v"(tid)); const int lane = tid & 63;
    const KArgs ka = kargs();
    float* xo = ka->out; const float* g = (const float*)ka->in[22];
    for (int m = F.gw; m < T; m += F.NGW) {
        f32x4* xr = (f32x4*)(xo + (size_t)m * DM) + lane; f32x4 v[4]; float s = 0.f;
#pragma unroll
        for (int j = 0; j < 4; ++j) { v[j] = xr[64 * j]; s += (v[j].x * v[j].x + v[j].y * v[j].y) + (v[j].z * v[j].z + v[j].w * v[j].w); }
        const float rstd = 1.0f / sqrtf(wave_sum(s) * (1.0f / DM) + EPS);
#pragma unroll
        for (int j = 0; j < 4; ++j) { const f32x4 gg = ((const f32x4*)g)[lane + 64 * j]; xr[64 * j] = v[j] * rstd * gg; }
    }
}

#ifndef PHMASK
#define PHMASK 0x7ffff
#endif
#ifndef DBLMASK
#define DBLMASK 0
#endif
#define REP(bit) for (int rep_ = 0; rep_ < ((DBLMASK & (bit)) ? 2 : 1); ++rep_)
__global__ void __launch_bounds__(NWAVES * 64, 2) fwd_kernel(Args args) {
    extern __shared__ __attribute__((aligned(16))) unsigned char lds[];
    Frame F;
    F.lds = (char*)lds; F.tid = threadIdx.x; F.lane = F.tid & 63; F.wave = __builtin_amdgcn_readfirstlane(F.tid >> 6);
    F.G = gridDim.x; { const int bx = blockIdx.x; F.vcu = (F.G % 8 == 0) ? (bx % 8) * (F.G / 8) + bx / 8 : bx; }
    F.gw = F.vcu * NWAVES + F.wave; F.NGW = F.G * NWAVES; F.ws = args.ws;
    unsigned char* ws = args.ws;
    volatile LAS unsigned* MISC = (volatile LAS unsigned*)((LAS unsigned char*)lds + MISC_OFF);
    if (F.tid < 16) MISC[F.tid] = 0u;
    __syncthreads();
    XcdBarrier bar = xcd_barrier_post((unsigned*)(ws + WS_CTL) + CW_BAR, MISC + 8);
    PG8_LAS unsigned char* ring = (PG8_LAS unsigned char*)lds;
    const int G = F.G, bx = (int)blockIdx.x;

    REP(1) if (PHMASK & 1) p0_prologue(F);
    xcd_barrier(bar);
    REP(2) if (PHMASK & 2) { pg8::Gemm g{(const bf16*)(ws + WS_HB), (const bf16*)(ws + WS_WIN), T, IN_PAD, DM}; pg8::StaticOrder S; S.init(T, IN_PAD, G, bx);
      pg8::EpiZ E{ws};
      pg8::gemm_phase<pg8::EpiZ, pg8::StaticOrder, true, false>(ring, g, S, E);
      const int nu = S.nwg, rem = nu % G;
      if (rem == 0) convert_late_weights(F, F.gw, F.NGW); else if (bx >= rem) convert_late_weights(F, (bx - rem) * NWAVES + F.wave, (G - rem) * NWAVES); }
    xcd_barrier(bar);
    REP(8) if (PHMASK & 8) { pg8::Gemm g{(const bf16*)(ws + WS_CQN), (const bf16*)(ws + WS_WUQ), T, 768, 256}; pg8::StaticOrder S; S.init(T, 768, G, bx);
      pg8::EpiBf<768> E{(bf16*)(ws + WS_QB)};
      pg8::gemm_phase<pg8::EpiBf<768>, pg8::StaticOrder, true, false>(ring, g, S, E); }
    REP(0x20000) if (PHMASK & 0x20000) { pg8::Gemm g{(const bf16*)(ws + WS_CKVN), (const bf16*)(ws + WS_WUKV), T, 1024, 256}; pg8::StaticOrder S; S.init(T, 1024, G, bx);
      pg8::EpiBf<1024> E{(bf16*)(ws + WS_KVB)};
      pg8::gemm_phase<pg8::EpiBf<1024>, pg8::StaticOrder, true, false>(ring, g, S, E); }
    xcd_barrier(bar);
    if (PHMASK & 16) { const bf16* QB = (const bf16*)(ws + WS_QB); const bf16* KVB = (const bf16*)(ws + WS_KVB); const bf16* KR = (const bf16*)(ws + WS_KR); bf16* Y = (bf16*)(ws + WS_Y);
      REP(16) for (int u = F.vcu; u < 512; u += G) { const int qb = u & 7, bh = u >> 3;
          att::mla::unit(bh >> 3, bh & 7, qb, QB, KVB, KR, (const float*)(ws + WS_COS), (const float*)(ws + WS_SIN), Y, (char*)lds); }
      REP(0x10000) if (PHMASK & 0x10000) for (int u = F.vcu; u < 512; u += G) { const int qb = u & 7, bh = u >> 3;
          att::wnd::unit(bh >> 3, bh & 7, qb, (const bf16*)(ws + WS_QA), (const bf16*)(ws + WS_KVA), (const float*)kargs()->in[3], (const float*)kargs()->in[6], Y, (char*)lds); } }
    xcd_barrier(bar);
    if (PHMASK & 32) p5_group_norm(F);
    xcd_barrier(bar);
    REP(64) if (PHMASK & 64) { pg8::Gemm g{(const bf16*)(ws + WS_Y), (const bf16*)(ws + WS_WOUT), T, DM, DM}; pg8::StaticOrder S; S.init(T, DM, G, bx);
      const KArgs ka = kargs(); pg8::EpiRes E{(const float*)ka->in[0], ka->out};
      pg8::gemm_phase<pg8::EpiRes, pg8::StaticOrder, true, false>(ring, g, S, E); }
    xcd_barrier(bar);
    REP(128) if (PHMASK & 128) p7_ffn_norm_router(F);
    xcd_barrier(bar);
    REP(256) if (PHMASK & 256) p8_topk_gather(F);
    xcd_barrier(bar);
    REP(512) if (PHMASK & 512) { pg8::Gemm g{(const bf16*)(ws + WS_HB), (const bf16*)(ws + WS_WGU), NBE * CAP, 1024, DM}; pg8::StaticOrder S; S.init(NBE * CAP, 1024, G, bx); S.bexp = 16;
      PG8_LAS int* gtab = (PG8_LAS int*)((PG8_LAS unsigned char*)lds + XTRA_OFF); const int* SEL = (const int*)(ws + WS_SEL);
      { pg8::Unit u; for (int i = 0; i < 15 && S.next(i, u); ++i) if (F.tid < 256) gtab[i * 256 + F.tid] = (u.pm >> 4) * SEQ + SEL[u.pm * CAP + F.tid]; }
      __syncthreads();
      pg8::EpiSwiGLU E{(bf16*)(ws + WS_ACT)};
      pg8::gemm_phase<pg8::EpiSwiGLU, pg8::StaticOrder, true, true>(ring, g, S, E, gtab); }
    xcd_barrier(bar);
    REP(1024) if (PHMASK & 1024) { pg8::Gemm g{(const bf16*)(ws + WS_ACT), (const bf16*)(ws + WS_WD), NBE * CAP, 1024, FF}; pg8::StaticOrder S; S.init(NBE * CAP, 1024, G, bx); S.bexp = 16;
      pg8::EpiDown E{(bf16*)(ws + WS_OB), (const float*)(ws + WS_VAL)};
      pg8::gemm_phase<pg8::EpiDown, pg8::StaticOrder, true, false>(ring, g, S, E); }
    xcd_barrier(bar);
    if (PHMASK & 2048) p11_combine_norm(F);
    xcd_barrier(bar);
    REP(4096) if (PHMASK & 4096) { pg8::Gemm g{(const bf16*)(ws + WS_PB), (const bf16*)(ws + WS_WPP), T, DM, PLE}; pg8::StaticOrder S; S.init(T, DM, G, bx);
      pg8::EpiBf<1024> E{(bf16*)(ws + WS_PROJ)};
      pg8::gemm_phase<pg8::EpiBf<1024>, pg8::StaticOrder, true, false>(ring, g, S, E); }
    if (PHMASK & 0x40000) { pg8::Gemm g{(const bf16*)(ws + WS_HB), (const bf16*)(ws + WS_WPG), T, DM, DM}; pg8::StaticOrder S; S.init(T, DM, G, bx);
      pg8::EpiPle E{kargs()->out, (const bf16*)(ws + WS_PROJ)};
      pg8::gemm_phase<pg8::EpiPle, pg8::StaticOrder, true, false>(ring, g, S, E); }
    xcd_barrier(bar);
    if (PHMASK & 8192) p13_final_norm(F);
}

extern "C" void kernel_launch(void* const* d_in, const int* in_sizes, int n_in, void* d_out, int out_size, void* d_ws, size_t ws_size, hipStream_t stream) {
    static int grid = 0;
    if (grid == 0) {
        if (n_in != 23 || in_sizes[0] != T * DM || out_size != T * DM || ws_size < WS_END) { fprintf(stderr, "kernel_launch: unexpected shapes: n_in %d in0 %d out %d ws %zu (need %zu)\n", n_in, n_in > 0 ? in_sizes[0] : -1, out_size, ws_size, (size_t)WS_END); grid = -1; return; }
        int dev = 0, cus = 0, per_cu = 0;
        if (hipGetDevice(&dev) != hipSuccess || hipDeviceGetAttribute(&cus, hipDeviceAttributeMultiprocessorCount, dev) != hipSuccess) { fprintf(stderr, "kernel_launch: device query failed\n"); grid = -1; return; }
        if (hipFuncSetAttribute((const void*)fwd_kernel, hipFuncAttributeMaxDynamicSharedMemorySize, LDS_BYTES) != hipSuccess) { fprintf(stderr, "kernel_launch: hipFuncSetAttribute failed\n"); grid = -1; return; }
        if (hipOccupancyMaxActiveBlocksPerMultiprocessor(&per_cu, (const void*)fwd_kernel, NWAVES * 64, LDS_BYTES) != hipSuccess || per_cu < 1) { fprintf(stderr, "kernel_launch: occupancy query says %d workgroups per CU\n", per_cu); (void)hipGetLastError(); }
        grid = cus;
    }
    if (grid < 0) return;
    if (hipMemsetAsync((char*)d_ws + WS_CTL, 0, CTL_ZERO_BYTES, stream) != hipSuccess) { fprintf(stderr, "kernel_launch: hipMemsetAsync failed\n"); return; }
    Args a{};
    for (int i = 0; i < 23; ++i) a.in[i] = d_in[i];
    a.out = (float*)d_out; a.ws = (unsigned char*)d_ws;
    hipLaunchKernelGGL(fwd_kernel, dim3(grid), dim3(NWAVES * 64), LDS_BYTES, stream, a);
    const hipError_t le = hipPeekAtLastError();
    if (le != hipSuccess) fprintf(stderr, "kernel_launch: launch failed: %s\n", hipGetErrorName(le));
}
```

```cpp
#include <hip/hip_runtime.h>
#include <hip/hip_bf16.h>
#include <cstdio>
#include <cstdint>

constexpr int BATCH = 8, SEQ = 2048, DM = 1024, T = BATCH * SEQ;
constexpr int IN_COLS = 1184, IN_PAD = 1280;
constexpr int NE = 16, FF = 512, CAP = 256, NBE = BATCH * NE;
constexpr int PLE = 256;
constexpr float EPS = 1e-6f;
constexpr float LOG2E = 1.4426950408889634f;

struct Args { const void* in[23]; float* out; unsigned char* ws; };
typedef const __attribute__((address_space(4))) Args* KArgs;
__device__ __forceinline__ KArgs kargs() { KArgs p = (KArgs)__builtin_amdgcn_kernarg_segment_ptr(); asm volatile("" : "+s"(p)); return p; }

constexpr size_t MiB = 1u << 20, KiB = 1u << 10;
constexpr size_t WS_CTL = 0, CTL_ZERO_BYTES = 64 * KiB;
constexpr size_t WS_WIN = 1 * MiB;
constexpr size_t WS_WUQ = WS_WIN + (size_t)IN_PAD * DM * 2;
constexpr size_t WS_WUKV = WS_WUQ + 768 * 256 * 2;
constexpr size_t WS_WOUT = WS_WUKV + 1024 * 256 * 2;
constexpr size_t WS_WPG = WS_WOUT + 2 * MiB;
constexpr size_t WS_WPP = WS_WPG + 2 * MiB;
constexpr size_t WS_WGU = 9 * MiB;
constexpr size_t WS_WD = WS_WGU + 32 * MiB;
constexpr size_t WS_COS = WS_WD + 16 * MiB, WS_SIN = WS_COS + 1 * MiB;
constexpr size_t WS_AFF = WS_SIN + 1 * MiB;
constexpr size_t WS_INV = WS_AFF + 1 * MiB;
constexpr size_t WS_SEL = WS_INV + 1 * MiB;
constexpr size_t WS_VAL = WS_SEL + 128 * KiB;
constexpr size_t WS_HB = 62 * MiB;
constexpr size_t WS_Y = 94 * MiB;
constexpr size_t WS_R1 = 126 * MiB;
constexpr size_t WS_QA = WS_R1;
constexpr size_t WS_KVA = WS_QA + 16 * MiB;
constexpr size_t WS_ZB = WS_KVA + 8 * MiB;
constexpr size_t WS_CQN = WS_ZB + 26 * MiB;
constexpr size_t WS_CKVN = WS_CQN + 8 * MiB;
constexpr size_t WS_KR = WS_CKVN + 8 * MiB;
constexpr size_t WS_QB = WS_KR + 1 * MiB;
constexpr size_t WS_KVB = WS_QB + 24 * MiB;
constexpr size_t WS_XG = WS_R1;
constexpr size_t WS_ACT = WS_R1 + 64 * MiB;
constexpr size_t WS_OB = WS_R1;
constexpr size_t WS_PROJ = WS_Y;
constexpr size_t WS_PB = WS_R1 + 96 * MiB;
constexpr size_t WS_END = 254 * MiB;
static_assert(WS_WPP + 1024 * 256 * 2 <= WS_WGU && WS_VAL + 128 * KiB <= WS_HB && WS_KVB + 32 * MiB <= WS_END && WS_PB + 8 * MiB <= WS_END, "d_ws map");
constexpr int CW_BAR = 1024;

constexpr int RING_BYTES = 131072;
constexpr int MISC_OFF = RING_BYTES;
constexpr int XTRA_OFF = RING_BYTES + 256;
constexpr int LDS_BYTES = 147456;
constexpr int NWAVES = 8;


namespace pg8 {
#define PG8_LAS __attribute__((address_space(3)))
typedef unsigned short bf16_t;
typedef short bf16x8 __attribute__((ext_vector_type(8)));
typedef float f32x4 __attribute__((ext_vector_type(4)));
typedef unsigned u32x4 __attribute__((ext_vector_type(4)));
constexpr int BM = 256, BK = 64, HALF = 128, HTB = HALF * BK * 2  , STAGE_BYTES = 8 * HTB, NXCD = 8, WGM = 8;

__host__ __device__ __forceinline__ int lds_byte(int r, int c) { const int st = (r >> 4) * 2 + (c >> 5), rr = r & 15, cc = c & 31, ob = rr * 64 + cc * 2; return st * 1024 + (ob ^ (((ob >> 9) & 1) << 5)); }
__host__ __device__ __forceinline__ void stage_rc(int b, int& R, int& C) { const int st = b / 1024, sb = b % 1024, swz = sb ^ (((sb >> 9) & 1) << 5); R = (st >> 1) * 16 + swz / 64; C = (st & 1) * 32 + (swz % 64) / 2; }
__host__ __device__ __forceinline__ int perm32(int rho) { const int n = rho >> 4, i = rho & 15; return 8 * (i >> 2) + 4 * n + (i & 3); }

struct Unit { int pm, pn; };
struct Gemm { const bf16_t* A; const bf16_t* Bt; int M, N, K; };

struct StaticOrder {
    int nM, nN, nwg, G, c, bexp;
    __host__ __device__ void init(int M, int N, int G_, int c_) { nM = M / BM; nN = N / BM; nwg = nM * nN; G = G_; c = c_; bexp = 0; }
    __host__ __device__ bool next(int i, Unit& u) const {
        const long L = (long)i * G + c; if (L >= nwg) return false;
        int wgid = (int)L; { const int q = nwg / NXCD, r = nwg % NXCD, xcd = wgid % NXCD, off = wgid / NXCD; wgid = (xcd < r ? xcd * (q + 1) : r * (q + 1) + (xcd - r) * q) + off; }
        const int nig = WGM * nN, gid = wgid / nig, fm = gid * WGM, gsz = (nM - fm) < WGM ? (nM - fm) : WGM;
        u.pm = fm + ((wgid % nig) % gsz); u.pn = (wgid % nig) / gsz; return true;
    }
    __device__ __forceinline__ int btile(const Unit& u) const { return bexp ? (u.pm & (bexp - 1)) * nN + u.pn : u.pn; }
    __device__ __forceinline__ void a_ready(const Unit&) const {}
    __device__ __forceinline__ void done(const Unit&) const {}
};


__device__ __forceinline__ unsigned cvt_pk_bf16(float lo, float hi) { unsigned r; asm volatile("v_cvt_pk_bf16_f32 %0, %1, %2" : "=v"(r) : "v"(lo), "v"(hi)); return r; }
#define EPI_DEFAULTS struct State {}; static constexpr bool HAS_MID = false, AFTER_DRAIN = false; static constexpr int MID_T = 0; \
    __device__ __forceinline__ void pre(State&, const Unit&, int, int, int, int) const {} \
    __device__ __forceinline__ void mid(State&, f32x4 (&)[2][2][4][2], const Unit&, int, int, int, int) const {}
__device__ __forceinline__ u32x4 pack8(const f32x4 v0, const f32x4 v1) { u32x4 w; w.x = cvt_pk_bf16(v0[0], v0[1]); w.y = cvt_pk_bf16(v0[2], v0[3]); w.z = cvt_pk_bf16(v1[0], v1[1]); w.w = cvt_pk_bf16(v1[2], v1[3]); return w; }
__device__ __forceinline__ float bflo(unsigned w) { return __builtin_bit_cast(float, w << 16); }
__device__ __forceinline__ float bfhi(unsigned w) { return __builtin_bit_cast(float, w & 0xffff0000u); }

struct EpiZ {
    static constexpr bool PERM = true; EPI_DEFAULTS
    unsigned char* ws;
    __device__ __forceinline__ void operator()(State&, const f32x4 (&acc)[2][2][4][2], const Unit& u, int wr, int wc, int fr, int fq) const {
        const int row0 = u.pm * BM + wr * 64 + fr, c8 = wc * 32 + 8 * fq;
        bf16_t* QA = (bf16_t*)(ws + WS_QA); bf16_t* KVA = (bf16_t*)(ws + WS_KVA);
        if (u.pn < 3) {
#pragma unroll
            for (int ai = 0; ai < 2; ++ai)
#pragma unroll
                for (int m = 0; m < 4; ++m) { const size_t row = (size_t)(row0 + ai * HALF + m * 16);
#pragma unroll
                    for (int bj = 0; bj < 2; ++bj) { const int col = bj * HALF + c8; const f32x4 v0 = acc[ai][bj][m][0], v1 = acc[ai][bj][m][1];
                        if (u.pn < 2) *(u32x4*)(QA + row * 512 + u.pn * 256 + col) = pack8(v0, v1);
                        else *(u32x4*)(KVA + row * 256 + col) = pack8(v0, v1); } }
            return;
        }
        const bool cq = (u.pn == 3);
        bf16_t* CQN = (bf16_t*)(ws + WS_CQN); bf16_t* CKVN = (bf16_t*)(ws + WS_CKVN); bf16_t* KR = (bf16_t*)(ws + WS_KR); const float* COS = (const float*)(ws + WS_COS); const float* SIN = (const float*)(ws + WS_SIN);
        const KArgs ka = kargs(); const float* g_cq = (const float*)ka->in[7]; const float* g_ckv = (const float*)ka->in[8];
        PG8_LAS float* P = (PG8_LAS float*)(XTRA_OFF);
#pragma unroll
        for (int ai = 0; ai < 2; ++ai)
#pragma unroll
            for (int m = 0; m < 4; ++m) { float s = 0.f;
#pragma unroll
                for (int bj = 0; bj < 2; ++bj) { if (bj == 1 && !cq) continue;
#pragma unroll
                    for (int n = 0; n < 2; ++n) { const f32x4 x = acc[ai][bj][m][n]; s += (x[0] * x[0] + x[1] * x[1]) + (x[2] * x[2] + x[3] * x[3]); } }
                s += __shfl_xor(s, 16); s += __shfl_xor(s, 32);
                if (fq == 0) P[(ai * HALF + wr * 64 + m * 16 + fr) * 4 + wc] = s; }
        asm volatile("s_waitcnt lgkmcnt(0)" ::: "memory"); __builtin_amdgcn_s_barrier(); asm volatile("" ::: "memory");
        const float inv_n = cq ? (1.0f / 256.0f) : (1.0f / 128.0f);
        f32x4 gv[2][2];
#pragma unroll
        for (int bj = 0; bj < 2; ++bj)
#pragma unroll
            for (int n = 0; n < 2; ++n) gv[bj][n] = cq ? *(const f32x4*)(g_cq + bj * HALF + c8 + 4 * n) : *(const f32x4*)(g_ckv + c8 + 4 * n);
#pragma unroll
        for (int ai = 0; ai < 2; ++ai)
#pragma unroll
            for (int m = 0; m < 4; ++m) { const int rl = ai * HALF + wr * 64 + m * 16 + fr; const size_t row = (size_t)(u.pm * BM + rl);
                const f32x4 pp = *(const PG8_LAS f32x4*)(P + rl * 4); const float rstd = 1.0f / sqrtf(((pp[0] + pp[1]) + (pp[2] + pp[3])) * inv_n + 1e-6f);
                if (cq) {
#pragma unroll
                    for (int bj = 0; bj < 2; ++bj) *(u32x4*)(CQN + row * 256 + bj * HALF + c8) = pack8(acc[ai][bj][m][0] * rstd * gv[bj][0], acc[ai][bj][m][1] * rstd * gv[bj][1]);
                } else {
                    *(u32x4*)(CKVN + row * 256 + c8) = pack8(acc[ai][0][m][0] * rstd * gv[0][0], acc[ai][0][m][1] * rstd * gv[0][1]);
                    *(u32x4*)(CKVN + row * 256 + HALF + c8) = (u32x4){0u, 0u, 0u, 0u};
                    if (wc == 0) { f32x4 mine0 = acc[ai][1][m][0], mine1 = acc[ai][1][m][1], oth0, oth1;
#pragma unroll
                        for (int i = 0; i < 4; ++i) { oth0[i] = __shfl_xor(mine0[i], 32); oth1[i] = __shfl_xor(mine1[i], 32); }
                        const int j0 = 8 * (fq & 1); const f32x4 cs0 = *(const f32x4*)(COS + row * 16 + j0), cs1 = *(const f32x4*)(COS + row * 16 + j0 + 4), sn0 = *(const f32x4*)(SIN + row * 16 + j0), sn1 = *(const f32x4*)(SIN + row * 16 + j0 + 4);
                        f32x4 r0, r1;
                        if (fq < 2) { r0 = mine0 * cs0 - oth0 * sn0; r1 = mine1 * cs1 - oth1 * sn1; }
                        else { r0 = oth0 * sn0 + mine0 * cs0; r1 = oth1 * sn1 + mine1 * cs1; }
                        *(u32x4*)(KR + row * 32 + 8 * fq) = pack8(r0, r1); } } }
    }
};
template <int ldc> struct EpiBf {
    static constexpr bool PERM = true; EPI_DEFAULTS
    bf16_t* O;
    __device__ __forceinline__ void operator()(State&, const f32x4 (&acc)[2][2][4][2], const Unit& u, int wr, int wc, int fr, int fq) const {
        const int row0 = u.pm * BM + wr * 64 + fr, c8 = u.pn * BM + wc * 32 + 8 * fq;
#pragma unroll
        for (int ai = 0; ai < 2; ++ai)
#pragma unroll
            for (int m = 0; m < 4; ++m) { bf16_t* rowp = O + (size_t)(row0 + ai * HALF + m * 16) * ldc + c8;
#pragma unroll
                for (int bj = 0; bj < 2; ++bj) *(u32x4*)(rowp + bj * HALF) = pack8(acc[ai][bj][m][0], acc[ai][bj][m][1]); }
    }
};
struct EpiRes {
    static constexpr bool PERM = false; EPI_DEFAULTS
    const float* base; float* out;
    __device__ __forceinline__ void operator()(State&, const f32x4 (&acc)[2][2][4][2], const Unit& u, int wr, int wc, int fr, int fq) const {
        const int row0 = u.pm * BM + wr * 64 + fr, c4 = u.pn * BM + wc * 32 + 4 * fq;
#pragma unroll
        for (int ai = 0; ai < 2; ++ai)
#pragma unroll
            for (int m = 0; m < 4; ++m) { const size_t off = (size_t)(row0 + ai * HALF + m * 16) * 1024 + c4;
#pragma unroll
                for (int bj = 0; bj < 2; ++bj)
#pragma unroll
                    for (int n = 0; n < 2; ++n) { const f32x4 b = *(const f32x4*)(base + off + bj * HALF + n * 16); *(f32x4*)(out + off + bj * HALF + n * 16) = b + acc[ai][bj][m][n]; } }
    }
};
struct EpiSwiGLU {
    static constexpr bool PERM = true; EPI_DEFAULTS
    bf16_t* ACT;
    __device__ __forceinline__ void operator()(State&, const f32x4 (&acc)[2][2][4][2], const Unit& u, int wr, int wc, int fr, int fq) const {
        const int row0 = u.pm * BM + wr * 64 + fr, c8 = u.pn * HALF + wc * 32 + 8 * fq;
#pragma unroll
        for (int ai = 0; ai < 2; ++ai)
#pragma unroll
            for (int m = 0; m < 4; ++m) { f32x4 r[2];
#pragma unroll
                for (int n = 0; n < 2; ++n)
#pragma unroll
                    for (int i = 0; i < 4; ++i) { const float g = acc[ai][0][m][n][i], up = acc[ai][1][m][n][i]; r[n][i] = g * __builtin_amdgcn_rcpf(1.0f + __expf(-g)) * up; }
                *(u32x4*)(ACT + (size_t)(row0 + ai * HALF + m * 16) * 512 + c8) = pack8(r[0], r[1]); }
    }
};
struct EpiDown {
    static constexpr bool PERM = true; EPI_DEFAULTS
    bf16_t* OB; const float* VAL;
    __device__ __forceinline__ void operator()(State&, const f32x4 (&acc)[2][2][4][2], const Unit& u, int wr, int wc, int fr, int fq) const {
        const int row0 = u.pm * BM + wr * 64 + fr, c8 = u.pn * BM + wc * 32 + 8 * fq;
#pragma unroll
        for (int ai = 0; ai < 2; ++ai)
#pragma unroll
            for (int m = 0; m < 4; ++m) { const int row = row0 + ai * HALF + m * 16; const float s = VAL[row]; bf16_t* rowp = OB + (size_t)row * 1024 + c8;
#pragma unroll
                for (int bj = 0; bj < 2; ++bj) *(u32x4*)(rowp + bj * HALF) = pack8(acc[ai][bj][m][0] * s, acc[ai][bj][m][1] * s); }
    }
};
struct EpiPle {
    static constexpr bool PERM = true; EPI_DEFAULTS
    float* out; const bf16_t* PROJ;
    __device__ __forceinline__ void operator()(State&, const f32x4 (&acc)[2][2][4][2], const Unit& u, int wr, int wc, int fr, int fq) const {
        const int row0 = u.pm * BM + wr * 64 + fr, c8 = u.pn * BM + wc * 32 + 8 * fq;
#pragma unroll
        for (int ai = 0; ai < 2; ++ai)
#pragma unroll
            for (int m = 0; m < 4; ++m) { const size_t off = (size_t)(row0 + ai * HALF + m * 16) * 1024 + c8;
#pragma unroll
                for (int bj = 0; bj < 2; ++bj) { float* op = out + off + bj * HALF; const u32x4 pw = *(const u32x4*)(PROJ + off + bj * HALF);
                    const f32x4 x0 = *(const f32x4*)op, x1 = *(const f32x4*)(op + 4); const f32x4 a0 = acc[ai][bj][m][0], a1 = acc[ai][bj][m][1];
                    f32x4 g0, g1;
#pragma unroll
                    for (int i = 0; i < 4; ++i) { g0[i] = __builtin_amdgcn_rcpf(1.0f + __expf(-a0[i])); g1[i] = __builtin_amdgcn_rcpf(1.0f + __expf(-a1[i])); }
                    f32x4 r0, r1;
                    r0[0] = x0[0] + g0[0] * bflo(pw.x); r0[1] = x0[1] + g0[1] * bfhi(pw.x); r0[2] = x0[2] + g0[2] * bflo(pw.y); r0[3] = x0[3] + g0[3] * bfhi(pw.y);
                    r1[0] = x1[0] + g1[0] * bflo(pw.z); r1[1] = x1[1] + g1[1] * bfhi(pw.z); r1[2] = x1[2] + g1[2] * bflo(pw.w); r1[3] = x1[3] + g1[3] * bfhi(pw.w);
                    *(f32x4*)op = r0; *(f32x4*)(op + 4) = r1; } }
    }
};

template <class Epi, class Sched, bool ALIGN_EPI = false, bool GATHER = false>
__device__ __forceinline__ void gemm_phase(PG8_LAS unsigned char* lds, const Gemm g, const Sched& S, const Epi& E, const PG8_LAS int* gtab = nullptr) {
    int tid_ = threadIdx.x; asm volatile("" : "+v"(tid_));
    const int tid = tid_, wid = __builtin_amdgcn_readfirstlane(tid >> 6), lane = tid & 63, wr = wid >> 2, wc = wid & 3, fr = lane & 15, fq = lane >> 4;
    const int K = g.K, nt = K / BK;
    unsigned voffA[2], voffB[2]; int stR[2], stC[2];
#pragma unroll
    for (int i = 0; i < 2; ++i) { int R, C; stage_rc(tid * 16 + i * 8192, R, C); const int Rb = Epi::PERM ? ((R & ~31) + perm32(R & 31)) : R; stR[i] = R; stC[i] = C;
        voffA[i] = (unsigned)(R * K + C) * 2u; voffB[i] = (unsigned)(Rb * K + C) * 2u; }
    const size_t kstep = (size_t)(BK * 2);
    const size_t hstep = (size_t)HALF * K * 2;
    const size_t tstep = 2 * hstep;
    const unsigned ldsw = (unsigned)wid * 1024u;
    const int aoff = lds_byte(wr * 64 + fr, fq * 8), boff = lds_byte(wc * 32 + fr, fq * 8);
#define PG8_SA(b, h) (((b) * 2 + (h)) * HTB)
#define PG8_SB(b, h) ((4 + (b) * 2 + (h)) * HTB)
#define PG8_STAGE(bufoff, gbase, voff) do { _Pragma("unroll") for (int _i = 0; _i < 2; ++_i) \
        __builtin_amdgcn_global_load_lds((const unsigned*)((const char*)(gbase) + (voff)[_i]), (PG8_LAS unsigned*)(lds + (bufoff) + ldsw + _i * 8192), 16, 0, 0); } while (0)
#define PG8_STAGE_A(bufoff, ub, uo, h, ko) do { if constexpr (GATHER) { PG8_STAGE(bufoff, (const char*)g.A + (ko), (uo)[h]); } else { PG8_STAGE(bufoff, (ub) + (size_t)(h) * hstep + (ko), voffA); } } while (0)
#define PG8_LDA(dst, b, h) do { _Pragma("unroll") for (int m = 0; m < 4; ++m) _Pragma("unroll") for (int k = 0; k < 2; ++k) dst[m][k] = *(const PG8_LAS bf16x8*)(lds + PG8_SA(b, h) + aoff + m * 2048 + k * 1024); } while (0)
#define PG8_LDB(dst, b, h) do { _Pragma("unroll") for (int n = 0; n < 2; ++n) _Pragma("unroll") for (int k = 0; k < 2; ++k) dst[n][k] = *(const PG8_LAS bf16x8*)(lds + PG8_SB(b, h) + boff + n * 2048 + k * 1024); } while (0)
#define PG8_MMA(ai, bj, At, Bt) do { __builtin_amdgcn_s_setprio(1); _Pragma("unroll") for (int m = 0; m < 4; ++m) _Pragma("unroll") for (int n = 0; n < 2; ++n) _Pragma("unroll") for (int k = 0; k < 2; ++k) \
        acc[ai][bj][m][n] = __builtin_amdgcn_mfma_f32_16x16x32_bf16(Bt[n][k], At[m][k], acc[ai][bj][m][n], 0, 0, 0); __builtin_amdgcn_s_setprio(0); } while (0)
#define PG8_WAIT_V(n) asm volatile("s_waitcnt vmcnt(" #n ")" ::: "memory")
#define PG8_WAIT_L(n) asm volatile("s_waitcnt lgkmcnt(" #n ")" ::: "memory")
#define PG8_BAR __builtin_amdgcn_s_barrier()
#define PG8_SCHED __builtin_amdgcn_sched_barrier(0)
#define PG8_GOFF(dst, uix) do { if constexpr (GATHER) { _Pragma("unroll") for (int _h = 0; _h < 2; ++_h) _Pragma("unroll") for (int _i = 0; _i < 2; ++_i) \
        dst[_h][_i] = (unsigned)(gtab[(uix) * 256 + _h * HALF + stR[_i]] * K + stC[_i]) * 2u; } } while (0)
    Unit cur, nxt; int ui = 0;
    if (!S.next(0, cur)) return;
    f32x4 acc[2][2][4][2];
#pragma unroll
    for (int a = 0; a < 2; ++a)
#pragma unroll
        for (int b = 0; b < 2; ++b)
#pragma unroll
            for (int m = 0; m < 4; ++m)
#pragma unroll
                for (int n = 0; n < 2; ++n) acc[a][b][m][n] = (f32x4){0.f, 0.f, 0.f, 0.f};
    bf16x8 At[4][2], B0[2][2], B1[2][2];
    unsigned co[2][2] = {{0u, 0u}, {0u, 0u}}, no[2][2] = {{0u, 0u}, {0u, 0u}};
    PG8_GOFF(co, 0);
    typename Epi::State st;
    const char* cA = (const char*)g.A + (size_t)cur.pm * tstep; const char* cB = (const char*)g.Bt + (size_t)S.btile(cur) * tstep;
    S.a_ready(cur);
    PG8_STAGE(PG8_SB(0, 0), cB, voffB); PG8_STAGE(PG8_SB(0, 1), cB + hstep, voffB); PG8_STAGE_A(PG8_SA(0, 0), cA, co, 0, 0); PG8_STAGE_A(PG8_SA(0, 1), cA, co, 1, 0);
    if (wr == 1) PG8_BAR;
    PG8_WAIT_V(2); PG8_BAR;
    PG8_STAGE(PG8_SB(1, 0), cB + kstep, voffB); PG8_STAGE_A(PG8_SA(1, 0), cA, co, 0, kstep); PG8_STAGE(PG8_SB(1, 1), cB + hstep + kstep, voffB);
    PG8_WAIT_V(6); PG8_BAR;
    for (;;) {
        const bool has_next = S.next(ui + 1, nxt);
        const char* nA = has_next ? (const char*)g.A + (size_t)nxt.pm * tstep : cA; const char* nB = has_next ? (const char*)g.Bt + (size_t)S.btile(nxt) * tstep : cB;
        if constexpr (GATHER) { if (has_next) PG8_GOFF(no, ui + 1); else {
#pragma unroll
            for (int h = 0; h < 2; ++h)
#pragma unroll
                for (int i = 0; i < 2; ++i) no[h][i] = co[h][i]; } }
        E.pre(st, cur, wr, wc, fr, fq);
#pragma nounroll
        for (int t = 0; t < nt; t += 2) {
            const bool last = (t == nt - 2);
            const size_t k1 = (size_t)(t + 1) * kstep, k2 = last ? 0 : (size_t)(t + 2) * kstep, k3 = k2 + kstep;
            const char* a2 = last ? nA : cA; const char* b2 = (last ? nB : cB) + k2; const char* b3 = b2 + kstep;
            unsigned so[2][2];
#pragma unroll
            for (int h = 0; h < 2; ++h)
#pragma unroll
                for (int i = 0; i < 2; ++i) so[h][i] = last ? no[h][i] : co[h][i];
            if (last && has_next) S.a_ready(nxt);
            if constexpr (Epi::HAS_MID) { if (t == Epi::MID_T) E.mid(st, acc, cur, wr, wc, fr, fq); }
            PG8_LDB(B0, 0, 0); PG8_LDB(B1, 0, 1); PG8_SCHED; PG8_LDA(At, 0, 0); PG8_STAGE_A(PG8_SA(1, 1), cA, co, 1, k1);
            PG8_WAIT_V(8); PG8_WAIT_L(0); PG8_BAR; PG8_MMA(0, 0, At, B0); PG8_MMA(0, 1, At, B1); PG8_BAR; PG8_SCHED;
            PG8_LDA(At, 0, 1); PG8_STAGE(PG8_SB(0, 0), b2, voffB); PG8_STAGE(PG8_SB(0, 1), b2 + hstep, voffB); PG8_STAGE_A(PG8_SA(0, 0), a2, so, 0, k2);
            PG8_WAIT_V(8); PG8_WAIT_L(0); PG8_BAR; PG8_MMA(1, 0, At, B0); PG8_MMA(1, 1, At, B1); PG8_BAR; PG8_SCHED;
            PG8_LDB(B0, 1, 0); PG8_LDB(B1, 1, 1); PG8_SCHED; PG8_LDA(At, 1, 0); PG8_STAGE_A(PG8_SA(0, 1), a2, so, 1, k2);
            PG8_WAIT_V(8); PG8_WAIT_L(0); PG8_BAR; PG8_MMA(0, 0, At, B0); PG8_MMA(0, 1, At, B1); PG8_BAR; PG8_SCHED;
            PG8_LDA(At, 1, 1); PG8_STAGE(PG8_SB(1, 0), b3, voffB); PG8_STAGE(PG8_SB(1, 1), b3 + hstep, voffB); PG8_STAGE_A(PG8_SA(1, 0), a2, so, 0, k3);
            PG8_WAIT_V(8); PG8_WAIT_L(0); PG8_BAR; PG8_MMA(1, 0, At, B0); PG8_MMA(1, 1, At, B1); PG8_BAR; PG8_SCHED;
        }
        if constexpr (ALIGN_EPI) { if (wr == 0) PG8_BAR; }
        if constexpr (!Epi::AFTER_DRAIN) { E(st, acc, cur, wr, wc, fr, fq); S.done(cur); }
        if (!has_next) break;
#pragma unroll
        for (int a = 0; a < 2; ++a)
#pragma unroll
            for (int b = 0; b < 2; ++b)
#pragma unroll
                for (int m = 0; m < 4; ++m)
#pragma unroll
                    for (int n = 0; n < 2; ++n) acc[a][b][m][n] = (f32x4){0.f, 0.f, 0.f, 0.f};
        cur = nxt; cA = nA; cB = nB; ++ui;
#pragma unroll
        for (int h = 0; h < 2; ++h)
#pragma unroll
            for (int i = 0; i < 2; ++i) co[h][i] = no[h][i];
        if constexpr (ALIGN_EPI) { if (wr == 1) PG8_BAR; }
    }
    PG8_WAIT_V(0);
    if constexpr (!ALIGN_EPI) { if (wr == 0) PG8_BAR; }
    PG8_BAR;
    if constexpr (Epi::AFTER_DRAIN) { E.fused(st, acc, cur, wr, wc, fr, fq, lds, wid, lane); S.done(cur); }
#undef PG8_SA
#undef PG8_SB
#undef PG8_STAGE
#undef PG8_STAGE_A
#undef PG8_LDA
#undef PG8_LDB
#undef PG8_MMA
#undef PG8_WAIT_V
#undef PG8_WAIT_L
#undef PG8_BAR
#undef PG8_SCHED
#undef PG8_GOFF
}
}

#define LAS __attribute__((address_space(3)))
#define GAS __attribute__((address_space(1)))
#define XB_TMO      128
#define XB_XCNT(j)  (256  + 64 * (j))
#define XB_XSUB(j)  (1280 + 64 * (j))
#define XB_XGEN(j)  (2304 + 64 * (j))
#define XB_TOP      3328
#define XB_TOPGEN   3392
#define XCD_BAR_WORDS 3456
#define XB_SPIN_CAP (1u << 18)

__device__ __forceinline__ unsigned xb_ld(unsigned* p)              { return __hip_atomic_load(p, __ATOMIC_RELAXED, __HIP_MEMORY_SCOPE_AGENT); }
__device__ __forceinline__ unsigned xb_add(unsigned* p, unsigned v) { return __hip_atomic_fetch_add(p, v, __ATOMIC_RELAXED, __HIP_MEMORY_SCOPE_AGENT); }
__device__ __forceinline__ unsigned xb_xcc_id() { return (unsigned)__builtin_amdgcn_s_getreg((3 << 11) | 20) & 0xFu; }
#define XB_SPIN(cond, bar) do { unsigned _sp = 0; while (cond) { __builtin_amdgcn_s_sleep(1); \
    if ((++_sp & 255u) == 0u) { if (xb_ld(&(bar)[XB_TMO])) break; if (_sp > XB_SPIN_CAP) { atomicAdd(&(bar)[XB_TMO], 1u); break; } } } } while (0)

struct XcdBarrier {
    unsigned* bar; unsigned x;
    volatile LAS unsigned* st;
};

__device__ __forceinline__ XcdBarrier xcd_barrier_post(unsigned* bar, volatile LAS unsigned* st) {
    XcdBarrier b; b.bar = bar; b.x = xb_xcc_id(); b.st = st;
    if (threadIdx.x == 0) (void)xb_add(&bar[XB_XCNT(b.x)], 1u);
    return b;
}
__device__ __forceinline__ void xcd_barrier_complete(unsigned* bar, unsigned x, unsigned& nloc, unsigned& nx) {
    const unsigned G = gridDim.x * gridDim.y * gridDim.z;
    unsigned sum, cnt, mine, sp = 0u;
    for (;;) {
        sum = 0u; cnt = 0u; mine = 0u;
#pragma unroll
        for (unsigned j = 0; j < 16; ++j) { const unsigned c = xb_ld(&bar[XB_XCNT(j)]); sum += c; cnt += (c > 0u) ? 1u : 0u; mine = (j == x) ? c : mine; }
        if (sum == G) break;
        __builtin_amdgcn_s_sleep(1);
        if ((++sp & 255u) == 0u) { if (xb_ld(&bar[XB_TMO])) break; if (sp > XB_SPIN_CAP) { atomicAdd(&bar[XB_TMO], 1u); break; } }
    }
    nloc = mine > 0u ? mine : 1u; nx = cnt > 0u ? cnt : 1u;
}

__device__ __forceinline__ void xcd_barrier(const XcdBarrier& b) {
    asm volatile("s_waitcnt vmcnt(0)" ::: "memory");
    __syncthreads();
    if (threadIdx.x == 0) {
        unsigned* bar = b.bar;
        __builtin_amdgcn_s_waitcnt(0);
        unsigned nloc = b.st[0], nx = b.st[1];
        if (nloc == 0u) { xcd_barrier_complete(bar, b.x, nloc, nx); b.st[0] = nloc; b.st[1] = nx; }
        const unsigned old = xb_add(&bar[XB_XSUB(b.x)], 1u);
        const unsigned gen = old / nloc;
        if (old + 1u == (gen + 1u) * nloc) {
            __builtin_amdgcn_fence(__ATOMIC_RELEASE, "agent");
            asm volatile("s_waitcnt vmcnt(0)" ::: "memory");
            const unsigned og = xb_add(&bar[XB_TOP], 1u);
            const unsigned tg = og / nx;
            if (og + 1u == (tg + 1u) * nx) xb_add(&bar[XB_TOPGEN], 1u);
            else XB_SPIN(xb_ld(&bar[XB_TOPGEN]) == tg, bar);
            __builtin_amdgcn_fence(__ATOMIC_ACQUIRE, "agent");
            xb_add(&bar[XB_XGEN(b.x)], 1u);
            asm volatile("s_waitcnt vmcnt(0)" ::: "memory");
        } else {
            XB_SPIN(xb_ld(&bar[XB_XGEN(b.x)]) == gen, bar);
            __builtin_amdgcn_fence(__ATOMIC_ACQUIRE, "agent");
            asm volatile("s_waitcnt vmcnt(0)" ::: "memory");
        }
    }
    __syncthreads();
}

typedef unsigned short bf16;
typedef unsigned v4u __attribute__((ext_vector_type(4)));
typedef unsigned v2u __attribute__((ext_vector_type(2)));
typedef float f32x4 __attribute__((ext_vector_type(4)));
typedef float f32x2_t __attribute__((ext_vector_type(2)));
typedef __bf16 bf16x2_t __attribute__((ext_vector_type(2)));
typedef short bf16x8 __attribute__((ext_vector_type(8)));
typedef short s16x4 __attribute__((ext_vector_type(4)));
typedef float f32x16 __attribute__((ext_vector_type(16)));
#define LDS_WAIT() asm volatile("s_waitcnt lgkmcnt(0)" ::: "memory")
#define VM_WAIT() asm volatile("s_waitcnt vmcnt(0)" ::: "memory")
#define SBAR() __builtin_amdgcn_sched_barrier(0)
__device__ __forceinline__ unsigned pk2(float lo, float hi) { f32x2_t v = {lo, hi}; bf16x2_t b = __builtin_convertvector(v, bf16x2_t); return __builtin_bit_cast(unsigned, b); }
__device__ __forceinline__ float bf2f(unsigned short h) { return __builtin_bit_cast(float, (unsigned)h << 16); }
__device__ __forceinline__ float wave_sum(float v) {
#pragma unroll
    for (int o = 1; o < 64; o <<= 1) v += __shfl_xor(v, o);
    return v;
}
__device__ const float INV_FREQ[16] = {1.000000000e+00f, 5.623413324e-01f, 3.162277639e-01f, 1.778279394e-01f, 1.000000015e-01f, 5.623412877e-02f, 3.162277862e-02f, 1.778279431e-02f,
                                       9.999999776e-03f, 5.623413250e-03f, 3.162277862e-03f, 1.778279431e-03f, 1.000000047e-03f, 5.623413017e-04f, 3.162277862e-04f, 1.778279402e-04f};

static_assert((CW_BAR + XCD_BAR_WORDS) * 4 <= (int)CTL_ZERO_BYTES, "CTL words inside the memset region");
namespace att {
#define KSWZ(row, colB) ((row) * 256 + ((colB) ^ (((row) & 7) << 4)))
__device__ __forceinline__ int crow(int r, int hi) { return (r & 3) + 8 * (r >> 2) + 4 * hi; }
__device__ __forceinline__ unsigned cvtpk(float lo, float hi) { return pk2(lo, hi); }
__device__ __forceinline__ int v_st(int k, int c) { const int kk = (k & ~0xC) | ((k & 4) << 1) | ((k & 8) >> 1); return ((kk >> 3) * 2 + (c >> 5)) * 512 + ((kk & 7) * 32 + (c & 31)) * 2; }
__device__ __forceinline__ int v_rd_base(int lane) { return ((lane & 3) << 3) | (((lane >> 2) & 3) << 6) | (((lane >> 4) & 1) << 5) | (((lane >> 5) & 1) << 8); }
constexpr int v_rd_off(int d0, int ks, int half) { return d0 * 512 + ks * 2048 + half * 1024; }
template <int OFF> __device__ __forceinline__ s16x4 tr_read(int vb) {
  s16x4 r; asm volatile("ds_read_b64_tr_b16 %0, %1 offset:%2" : "=&v"(r) : "v"(vb), "i"(OFF) : "memory"); return r;
}
template <int D0> __device__ __forceinline__ void pv_one(f32x16& od, int vb, bf16x8 pa0, bf16x8 pa1, bf16x8 pa2, bf16x8 pa3) {
  const s16x4 l0 = tr_read<v_rd_off(D0, 0, 0)>(vb), h0 = tr_read<v_rd_off(D0, 0, 1)>(vb), l1 = tr_read<v_rd_off(D0, 1, 0)>(vb), h1 = tr_read<v_rd_off(D0, 1, 1)>(vb);
  const s16x4 l2 = tr_read<v_rd_off(D0, 2, 0)>(vb), h2 = tr_read<v_rd_off(D0, 2, 1)>(vb), l3 = tr_read<v_rd_off(D0, 3, 0)>(vb), h3 = tr_read<v_rd_off(D0, 3, 1)>(vb);
  asm volatile("s_waitcnt lgkmcnt(0)" ::: "memory"); SBAR();
#define PK(L, H) (bf16x8){L[0], L[1], L[2], L[3], H[0], H[1], H[2], H[3]}
  od = __builtin_amdgcn_mfma_f32_32x32x16_bf16(pa0, PK(l0, h0), od, 0, 0, 0);
  od = __builtin_amdgcn_mfma_f32_32x32x16_bf16(pa1, PK(l1, h1), od, 0, 0, 0);
  od = __builtin_amdgcn_mfma_f32_32x32x16_bf16(pa2, PK(l2, h2), od, 0, 0, 0);
  od = __builtin_amdgcn_mfma_f32_32x32x16_bf16(pa3, PK(l3, h3), od, 0, 0, 0);
#undef PK
}
__device__ __forceinline__ void pv_2(f32x16* o, int vb, bf16x8 pa0, bf16x8 pa1, bf16x8 pa2, bf16x8 pa3) {
  pv_one<0>(o[0], vb, pa0, pa1, pa2, pa3); pv_one<1>(o[1], vb, pa0, pa1, pa2, pa3);
}
__device__ __forceinline__ void pack_p(const f32x16& p0, const f32x16& p1, bf16x8& pa0, bf16x8& pa1, bf16x8& pa2, bf16x8& pa3) {
#define PK4(P, BASE, OUT) do { unsigned a0 = cvtpk(P[BASE + 0], P[BASE + 1]), a1 = cvtpk(P[BASE + 2], P[BASE + 3]);   \
    unsigned b0 = cvtpk(P[BASE + 4], P[BASE + 5]), b1 = cvtpk(P[BASE + 6], P[BASE + 7]);                              \
    auto r0 = __builtin_amdgcn_permlane32_swap(a0, b0, false, false); auto r1 = __builtin_amdgcn_permlane32_swap(a1, b1, false, false); \
    v4u w = {r0[0], r1[0], r0[1], r1[1]}; OUT = __builtin_bit_cast(bf16x8, w); } while (0)
  PK4(p0, 0, pa0); PK4(p0, 8, pa1); PK4(p1, 0, pa2); PK4(p1, 8, pa3);
#undef PK4
}

namespace mla {
constexpr int NW = 8, QBLK = 32, KVBLK = 64;
constexpr float SCALE = 0.10206207261596575f;
constexpr float THR = 8.f;
constexpr int SHM_V = 8192, SHM_K = 16384, SHM_TOTAL = 2 * SHM_V + 2 * SHM_K + NW * 64 * 4;
__device__ __forceinline__ void partialSM(f32x16& p0, f32x16& p1, float& m_reg, float& mn, float& alpha) {
  constexpr float C = SCALE * LOG2E;
  float pmax = p0[0];
#pragma unroll
  for (int r = 1; r < 16; ++r) pmax = fmaxf(pmax, p0[r]);
#pragma unroll
  for (int r = 0; r < 16; ++r) pmax = fmaxf(pmax, p1[r]);
  { auto rr = __builtin_amdgcn_permlane32_swap(__float_as_uint(pmax), __float_as_uint(pmax), false, false);
    pmax = fmaxf(__uint_as_float(rr[0]), __uint_as_float(rr[1])); }
  if (__builtin_expect(__all(pmax - m_reg <= THR / SCALE), 1)) { mn = m_reg; alpha = 1.f; }
  else { mn = fmaxf(m_reg, pmax); alpha = __builtin_amdgcn_exp2f((m_reg - mn) * C); m_reg = mn; }
  const float mnC = -mn * C;
#pragma unroll
  for (int r = 0; r < 16; ++r) p0[r] = fmaf(p0[r], C, mnC);
#pragma unroll
  for (int r = 0; r < 16; ++r) p1[r] = fmaf(p1[r], C, mnC);
#pragma unroll
  for (int r = 0; r < 16; ++r) p0[r] = __builtin_amdgcn_exp2f(p0[r]);
}
__device__ __forceinline__ void finishSM(f32x16& p0, f32x16& p1, float alpha, float& l_reg, bf16x8& pa0, bf16x8& pa1, bf16x8& pa2, bf16x8& pa3) {
#pragma unroll
  for (int r = 0; r < 16; ++r) p1[r] = __builtin_amdgcn_exp2f(p1[r]);
  float ps = 0;
#pragma unroll
  for (int r = 0; r < 16; ++r) ps += p0[r];
#pragma unroll
  for (int r = 0; r < 16; ++r) ps += p1[r];
  { auto rr = __builtin_amdgcn_permlane32_swap(__float_as_uint(ps), __float_as_uint(ps), false, false);
    ps = __uint_as_float(rr[0]) + __uint_as_float(rr[1]); }
  l_reg = l_reg * alpha + ps;
  pack_p(p0, p1, pa0, pa1, pa2, pa3);
}
__device__ __forceinline__ void qkt(f32x16& p0, f32x16& p1, const char* Ks, const bf16x8* qr, int r32, int hi) {
  p0 = f32x16{}; p1 = f32x16{};
#pragma unroll
  for (int d0 = 0; d0 < 6; ++d0) { const int cb = (d0 * 16 + hi * 8) * 2;
    const bf16x8 b0 = *reinterpret_cast<const bf16x8*>(Ks + KSWZ(r32, cb));
    const bf16x8 b1 = *reinterpret_cast<const bf16x8*>(Ks + KSWZ(32 + r32, cb));
    p0 = __builtin_amdgcn_mfma_f32_32x32x16_bf16(b0, qr[d0], p0, 0, 0, 0);
    p1 = __builtin_amdgcn_mfma_f32_32x32x16_bf16(b1, qr[d0], p1, 0, 0, 0); }
}
__device__ __forceinline__ void unit(int b, int h, int qb, const bf16* __restrict__ QB, const bf16* __restrict__ KVB, const bf16* __restrict__ KR,
                                     const float* __restrict__ COS, const float* __restrict__ SIN, bf16* __restrict__ Y, char* lds) {
  int tid_ = threadIdx.x; asm volatile("" : "+v"(tid_));
  const int tid = tid_, wid = tid >> 6, lane = tid & 63, r32 = lane & 31, hi = lane >> 5;
  char* V_lds = lds; char* K_lds = lds + 2 * SHM_V;
  float* ws = (float*)(lds + 2 * SHM_V + 2 * SHM_K) + wid * 64; float* li_l = ws; float* al_l = ws + 32;
  float m_reg = -1e30f, l_reg = 0; f32x16 o[2] = {}; bf16x8 qr[6];
  const size_t tokq = (size_t)b * SEQ + qb * 256 + wid * QBLK + r32;
  { const bf16* Qw = QB + tokq * 768 + h * 96 + hi * 8;
#pragma unroll
    for (int d0 = 0; d0 < 6; ++d0) qr[d0] = *reinterpret_cast<const bf16x8*>(Qw + d0 * 16);
    const f32x4 c0 = *(const f32x4*)(COS + tokq * 16 + hi * 8), c1 = *(const f32x4*)(COS + tokq * 16 + hi * 8 + 4);
    const f32x4 s0 = *(const f32x4*)(SIN + tokq * 16 + hi * 8), s1 = *(const f32x4*)(SIN + tokq * 16 + hi * 8 + 4);
    float o1[8], o2[8];
#pragma unroll
    for (int j = 0; j < 8; ++j) { const float t1 = bf2f((unsigned short)qr[4][j]), t2 = bf2f((unsigned short)qr[5][j]); const float c = j < 4 ? c0[j & 3] : c1[j & 3], s = j < 4 ? s0[j & 3] : s1[j & 3];
      o1[j] = t1 * c - t2 * s; o2[j] = t1 * s + t2 * c; }
    v4u w1 = {pk2(o1[0], o1[1]), pk2(o1[2], o1[3]), pk2(o1[4], o1[5]), pk2(o1[6], o1[7])}, w2 = {pk2(o2[0], o2[1]), pk2(o2[2], o2[3]), pk2(o2[4], o2[5]), pk2(o2[6], o2[7])};
    qr[4] = __builtin_bit_cast(bf16x8, w1); qr[5] = __builtin_bit_cast(bf16x8, w2); }
  const int ksr = tid >> 4, kcc = tid & 15, kc = kcc < 12 ? kcc : kcc - 4;
  const bf16* kbase = kc < 8 ? KVB + ((size_t)b * SEQ + ksr) * 1024 + h * 128 + kc * 8 : KR + ((size_t)b * SEQ + ksr) * 32 + (kc - 8) * 8;
  const int kstr = kc < 8 ? 1024 : 32;
  const int vrow = tid >> 3, vcc = tid & 7;
  const bf16* vbase = KVB + ((size_t)b * SEQ + vrow) * 1024 + h * 128 + 64 + vcc * 8;
  const int kst0 = KSWZ(ksr, kc * 16), kst1 = KSWZ(32 + ksr, kc * 16), vst = v_st(vrow, vcc * 8);
  const int vb0 = (int)(uintptr_t)V_lds + v_rd_base(lane);
  struct { bf16x8 vs, ks0, ks1; } sr_[2];
#define SLOAD(i, k0) do { sr_[i].vs = *reinterpret_cast<const bf16x8*>(vbase + (size_t)(k0) * 1024); \
    sr_[i].ks0 = *reinterpret_cast<const bf16x8*>(kbase + (size_t)(k0) * kstr); sr_[i].ks1 = *reinterpret_cast<const bf16x8*>(kbase + (size_t)((k0) + 32) * kstr); } while (0)
#define SWRITE(bb, i) do { *(bf16x8*)(V_lds + (bb) * SHM_V + vst) = sr_[i].vs; *(bf16x8*)(K_lds + (bb) * SHM_K + kst0) = sr_[i].ks0; *(bf16x8*)(K_lds + (bb) * SHM_K + kst1) = sr_[i].ks1; } while (0)
#define SWAIT() asm volatile("s_waitcnt vmcnt(3)" ::: "memory")
#define RESC(a) do { if (__any((a) < 1.f)) { if (hi == 0) al_l[r32] = (a); asm volatile("s_waitcnt lgkmcnt(0)" ::: "memory"); \
    _Pragma("unroll") for (int d = 0; d < 2; ++d) _Pragma("unroll") for (int r = 0; r < 16; ++r) o[d][r] *= al_l[crow(r, hi)]; } } while (0)
  f32x16 pA0, pA1, pB0, pB1; float mnA, mnB, alA, alB; bf16x8 pa0, pa1, pa2, pa3; constexpr int NT = SEQ / KVBLK;
  constexpr int SE = 0, SO = 1;
  SLOAD(SE, 0); asm volatile("s_waitcnt vmcnt(0)" ::: "memory"); SWRITE(0, SE); __syncthreads();
  qkt(pA0, pA1, K_lds, qr, r32, hi); partialSM(pA0, pA1, m_reg, mnA, alA);
  SLOAD(SO, KVBLK); SLOAD(SE, 2 * KVBLK);
  SWAIT(); SWRITE(1, SO); __syncthreads();
  for (int j = 1; j + 1 < NT; j += 2) {
    SBAR(); qkt(pB0, pB1, K_lds + SHM_K, qr, r32, hi);
    finishSM(pA0, pA1, alA, l_reg, pa0, pa1, pa2, pa3); SBAR();
    SLOAD(SO, (j + 2) * KVBLK); SBAR();
    pv_2(o, vb0, pa0, pa1, pa2, pa3); partialSM(pB0, pB1, m_reg, mnB, alB);
    __syncthreads(); SWAIT(); SWRITE(0, SE);
    RESC(alB); __syncthreads();
    SBAR(); qkt(pA0, pA1, K_lds, qr, r32, hi);
    finishSM(pB0, pB1, alB, l_reg, pa0, pa1, pa2, pa3); SBAR();
    if (j + 3 < NT) SLOAD(SE, (j + 3) * KVBLK); SBAR();
    pv_2(o, vb0 + SHM_V, pa0, pa1, pa2, pa3); partialSM(pA0, pA1, m_reg, mnA, alA);
    __syncthreads(); SWAIT(); SWRITE(1, SO);
    RESC(alA); __syncthreads();
  }
  SBAR(); qkt(pB0, pB1, K_lds + SHM_K, qr, r32, hi);
  finishSM(pA0, pA1, alA, l_reg, pa0, pa1, pa2, pa3); SBAR();
  pv_2(o, vb0, pa0, pa1, pa2, pa3); partialSM(pB0, pB1, m_reg, mnB, alB);
  __syncthreads(); RESC(alB);
  finishSM(pB0, pB1, alB, l_reg, pa0, pa1, pa2, pa3); SBAR();
  pv_2(o, vb0 + SHM_V, pa0, pa1, pa2, pa3);
  if (hi == 0) li_l[r32] = l_reg; asm volatile("s_waitcnt lgkmcnt(0)" ::: "memory");
  float rli[16];
#pragma unroll
  for (int r = 0; r < 16; ++r) rli[r] = __builtin_amdgcn_rcpf(li_l[crow(r, hi)]);
  bf16* Ow = Y + ((size_t)b * SEQ + qb * 256 + wid * QBLK) * 1024 + 512 + h * 64;
#pragma unroll
  for (int r = 0; r < 16; ++r) { const int orow = crow(r, hi);
#pragma unroll
    for (int d0 = 0; d0 < 2; ++d0) Ow[(size_t)orow * 1024 + d0 * 32 + r32] = (bf16)(pk2(o[d0][r] * rli[r], 0.f) & 0xffffu); }
  __syncthreads();
#undef SLOAD
#undef SWRITE
#undef SWAIT
#undef RESC
}
}

namespace wnd {
constexpr int LDS_V = 0, LDS_K = 8192, LDS_TAB = 8192 + 16384, LDS_WS = LDS_TAB + 2048, LDS_TOTAL = LDS_WS + 8 * 256;
__device__ __forceinline__ int t5_bucket(int rel) {
  const int n = rel < 0 ? -rel : rel; int bk;
  if (n < 8) bk = n; else bk = 8 + (n > 11) + (n > 15) + (n > 22) + (n > 31) + (n > 45) + (n > 63) + (n > 90);
  return (rel > 0 ? 16 : 0) + bk;
}
__device__ __forceinline__ void unit(int b, int h, int qb, const bf16* __restrict__ QA, const bf16* __restrict__ KVA, const float* __restrict__ rel_bias, const float* __restrict__ sink,
                                     bf16* __restrict__ Y, char* lds) {
  int tid_ = threadIdx.x; asm volatile("" : "+v"(tid_));
  const int tid = tid_, wid = tid >> 6, lane = tid & 63, r32 = lane & 31, hi = lane >> 5, kvh = h >> 2;
  char* V_lds = lds + LDS_V; char* K_lds = lds + LDS_K; float* tab = (float*)(lds + LDS_TAB); float* al_l = (float*)(lds + LDS_WS) + wid * 64; float* li_l = al_l + 32;
  for (int i = tid; i < 385; i += 512) { const int rel = i - 192, n = rel < 0 ? -rel : rel; tab[i] = n <= 128 ? rel_bias[t5_bucket(rel) * 8 + h] * LOG2E : -1e30f; }
  const int q0 = qb * 256;
  bf16x8 qr[4];
  { const bf16* Qw = QA + ((size_t)b * SEQ + q0 + wid * 32 + r32) * 512 + h * 64 + hi * 8;
#pragma unroll
    for (int d0 = 0; d0 < 4; ++d0) qr[d0] = *reinterpret_cast<const bf16x8*>(Qw + d0 * 16); }
  float m_reg = sink[h] * LOG2E, l_reg = 1.0f; f32x16 o[2] = {};
  const int srow = tid >> 3, scc = tid & 7;
  const bf16* kbase = KVA + (size_t)b * SEQ * 256 + kvh * 64 + scc * 8; const bf16* vbase = kbase + 128;
  const int kst = KSWZ(srow, scc * 16), vst = v_st(srow, scc * 8);
  const int vb0 = (int)(uintptr_t)V_lds + v_rd_base(lane);
  constexpr float C = 0.125f * LOG2E;
  const int t_lo = qb == 0 ? 2 : 0, t_hi = qb == SEQ / 256 - 1 ? 6 : 8, wlo = wid >> 1;
  for (int t = t_lo; t < t_hi; ++t) {
    const int k0 = q0 - 128 + 64 * t;
    const bf16x8 kreg = *reinterpret_cast<const bf16x8*>(kbase + (size_t)(k0 + srow) * 256), vreg = *reinterpret_cast<const bf16x8*>(vbase + (size_t)(k0 + srow) * 256);
    __syncthreads();
    *(bf16x8*)(K_lds + kst) = kreg; *(bf16x8*)(V_lds + vst) = vreg;
    __syncthreads();
    if (t >= wlo && t <= wlo + 4) {
      f32x16 p0 = {}, p1 = {};
#pragma unroll
      for (int d0 = 0; d0 < 4; ++d0) { const int cb = (d0 * 16 + hi * 8) * 2;
        const bf16x8 b0 = *reinterpret_cast<const bf16x8*>(K_lds + KSWZ(r32, cb)), b1 = *reinterpret_cast<const bf16x8*>(K_lds + KSWZ(32 + r32, cb));
        p0 = __builtin_amdgcn_mfma_f32_32x32x16_bf16(b0, qr[d0], p0, 0, 0, 0); p1 = __builtin_amdgcn_mfma_f32_32x32x16_bf16(b1, qr[d0], p1, 0, 0, 0); }
      const int base = k0 - (q0 + wid * 32 + r32) + 192 + 4 * hi;
#pragma unroll
      for (int r = 0; r < 16; ++r) { const int i0 = base + (r & 3) + 8 * (r >> 2); p0[r] = fmaf(p0[r], C, tab[i0]); p1[r] = fmaf(p1[r], C, tab[i0 + 32]); }
      float pmax = p0[0];
#pragma unroll
      for (int r = 1; r < 16; ++r) pmax = fmaxf(pmax, p0[r]);
#pragma unroll
      for (int r = 0; r < 16; ++r) pmax = fmaxf(pmax, p1[r]);
      { auto rr = __builtin_amdgcn_permlane32_swap(__float_as_uint(pmax), __float_as_uint(pmax), false, false); pmax = fmaxf(__uint_as_float(rr[0]), __uint_as_float(rr[1])); }
      const float mn = fmaxf(m_reg, pmax), alpha = __builtin_amdgcn_exp2f(m_reg - mn); m_reg = mn;
      float ps = 0.f;
#pragma unroll
      for (int r = 0; r < 16; ++r) { p0[r] = __builtin_amdgcn_exp2f(p0[r] - mn); p1[r] = __builtin_amdgcn_exp2f(p1[r] - mn); ps += p0[r] + p1[r]; }
      { auto rr = __builtin_amdgcn_permlane32_swap(__float_as_uint(ps), __float_as_uint(ps), false, false); ps = __uint_as_float(rr[0]) + __uint_as_float(rr[1]); }
      l_reg = l_reg * alpha + ps;
      if (__any(alpha < 1.f)) { if (hi == 0) al_l[r32] = alpha; asm volatile("s_waitcnt lgkmcnt(0)" ::: "memory");
#pragma unroll
        for (int d = 0; d < 2; ++d)
#pragma unroll
          for (int r = 0; r < 16; ++r) o[d][r] *= al_l[crow(r, hi)]; }
      bf16x8 pa0, pa1, pa2, pa3; pack_p(p0, p1, pa0, pa1, pa2, pa3);
      SBAR(); pv_2(o, vb0, pa0, pa1, pa2, pa3);
    }
  }
  if (hi == 0) li_l[r32] = l_reg; asm volatile("s_waitcnt lgkmcnt(0)" ::: "memory");
  float rli[16];
#pragma unroll
  for (int r = 0; r < 16; ++r) rli[r] = __builtin_amdgcn_rcpf(li_l[crow(r, hi)]);
  bf16* Ow = Y + ((size_t)b * SEQ + q0 + wid * 32) * 1024 + h * 64;
#pragma unroll
  for (int r = 0; r < 16; ++r) { const int orow = crow(r, hi);
#pragma unroll
    for (int d0 = 0; d0 < 2; ++d0) Ow[(size_t)orow * 1024 + d0 * 32 + r32] = (bf16)(pk2(o[d0][r] * rli[r], 0.f) & 0xffffu); }
  __syncthreads();
}
}
#undef KSWZ
}

struct Frame {
    char* lds; int tid, lane, wave, vcu, G, gw, NGW;
    unsigned char* ws;
};

__device__ __forceinline__ void transpose_item(const float* __restrict__ W, int N, int k0, int n0, bf16* dst  , int ldk, float* scr, int lane) {
    f32x4 v[8];
#pragma unroll
    for (int q = 0; q < 8; ++q) v[q] = *(const f32x4*)(W + (size_t)(k0 + 8 * q + (lane >> 3)) * N + n0 + 4 * (lane & 7));
#pragma unroll
    for (int q = 0; q < 8; ++q) { float* s = scr + (8 * q + (lane >> 3)) * 33 + 4 * (lane & 7); s[0] = v[q].x; s[1] = v[q].y; s[2] = v[q].z; s[3] = v[q].w; }
    LDS_WAIT(); asm volatile("" ::: "memory");
    const int c = lane & 7;
#pragma unroll
    for (int j = 0; j < 4; ++j) { const int n = (lane >> 3) + 8 * j; const float* s = scr + (8 * c) * 33 + n;
        v4u o; o.x = pk2(s[0 * 33], s[1 * 33]); o.y = pk2(s[2 * 33], s[3 * 33]); o.z = pk2(s[4 * 33], s[5 * 33]); o.w = pk2(s[6 * 33], s[7 * 33]);
        *(v4u*)(dst + (size_t)n * ldk + k0 + 8 * c) = o; }
    LDS_WAIT(); asm volatile("" ::: "memory");
}

__device__ __forceinline__ void p0_prologue(const Frame& F) {
    int tid = threadIdx.x; asm volatile("" : "+v"(tid)); const int lane = tid & 63;
    const KArgs ka = kargs();
    float* scr = (float*)(F.lds + F.wave * 16384);
    unsigned char* ws = F.ws;
    const float* w_in = (const float*)ka->in[5]; const float* w_uq = (const float*)ka->in[9]; const float* w_ukv = (const float*)ka->in[10];
    constexpr int I_IN = 16 * 37, I_UQ = 4 * 24, I_UKV = 2 * 32;
    constexpr int NITEMS = I_IN + I_UQ + I_UKV;
    for (int it = F.gw; it < NITEMS; it += F.NGW) {
        int r = it;
        if (r < I_IN) { const int kb = r / 37, nb = r % 37; transpose_item(w_in, IN_COLS, 64 * kb, 32 * nb, (bf16*)(ws + WS_WIN) + (size_t)(32 * nb) * 1024, 1024, scr, lane); continue; } r -= I_IN;
        if (r < I_UQ) { const int kb = r / 24, nb = r % 24; transpose_item(w_uq, 768, 64 * kb, 32 * nb, (bf16*)(ws + WS_WUQ) + (size_t)(32 * nb) * 256, 256, scr, lane); continue; } r -= I_UQ;
        { const int kb = r / 32, nb = r % 32; transpose_item(w_ukv, 1024, 64 * kb, 32 * nb, (bf16*)(ws + WS_WUKV) + (size_t)(32 * nb) * 256, 256, scr, lane); }
    }
    const int gt = F.vcu * 512 + tid, NGT = F.G * 512;
    for (int i = gt; i < 96 * 128; i += NGT) ((v4u*)((bf16*)(ws + WS_WIN) + (size_t)IN_COLS * 1024))[i] = (v4u){0u, 0u, 0u, 0u};
    for (int i = gt; i < 1024 * 16; i += NGT) *(v4u*)((bf16*)(ws + WS_WUKV) + (size_t)(i >> 4) * 256 + 128 + (i & 15) * 8) = (v4u){0u, 0u, 0u, 0u};
    const int* positions = (const int*)ka->in[2];
    for (int i = gt; i < T * 16; i += NGT) {
        const float ang = (float)positions[i >> 4] * INV_FREQ[i & 15];
        const double x = (double)ang, q = __builtin_rint(x * 0.63661977236758134308);
        const double r = (x - q * 1.5707963267948966192) - q * 6.123233995736766036e-17, r2 = r * r;
        const double sn = r * (1.0 + r2 * (-1.0 / 6 + r2 * (1.0 / 120 + r2 * (-1.0 / 5040 + r2 * (1.0 / 362880 + r2 * (-1.0 / 39916800 + r2 * (1.0 / 6227020800.0)))))));
        const double cs = 1.0 + r2 * (-0.5 + r2 * (1.0 / 24 + r2 * (-1.0 / 720 + r2 * (1.0 / 40320 + r2 * (-1.0 / 3628800 + r2 * (1.0 / 479001600.0 + r2 * (-1.0 / 87178291200.0)))))));
        const int qi = (int)((long long)q & 3);
        const double c_ = (qi == 0) ? cs : (qi == 1) ? -sn : (qi == 2) ? -cs : sn, s_ = (qi == 0) ? sn : (qi == 1) ? cs : (qi == 2) ? -sn : -cs;
        ((float*)(ws + WS_COS))[i] = (float)c_; ((float*)(ws + WS_SIN))[i] = (float)s_;
    }
    const float* x = (const float*)ka->in[0]; const float* g = (const float*)ka->in[4]; bf16* H = (bf16*)(ws + WS_HB);
    for (int m = F.gw; m < T; m += F.NGW) {
        const f32x4* xr = (const f32x4*)(x + (size_t)m * DM) + lane; f32x4 v[4]; float s = 0.f;
#pragma unroll
        for (int j = 0; j < 4; ++j) { v[j] = xr[64 * j]; s += (v[j].x * v[j].x + v[j].y * v[j].y) + (v[j].z * v[j].z + v[j].w * v[j].w); }
        const float rstd = 1.0f / sqrtf(wave_sum(s) * (1.0f / DM) + EPS);
        unsigned long long* o8 = (unsigned long long*)(H + (size_t)m * DM) + lane;
#pragma unroll
        for (int j = 0; j < 4; ++j) { const f32x4 gg = ((const f32x4*)g)[lane + 64 * j];
            o8[64 * j] = (unsigned long long)pk2(v[j].x * rstd * gg.x, v[j].y * rstd * gg.y) | ((unsigned long long)pk2(v[j].z * rstd * gg.z, v[j].w * rstd * gg.w) << 32); }
    }
}

__device__ __forceinline__ void convert_late_weights(const Frame& F, int widx, int nw) {
    int lane_ = threadIdx.x & 63; asm volatile("" : "+v"(lane_));
    const KArgs ka = kargs(); unsigned char* ws = F.ws; float* scr = (float*)(F.lds + F.wave * 16384);
    const float* w_out = (const float*)ka->in[13]; const float* w_eg = (const float*)ka->in[16]; const float* w_eu = (const float*)ka->in[17]; const float* w_ed = (const float*)ka->in[18];
    const float* w_pg = (const float*)ka->in[20]; const float* w_pp = (const float*)ka->in[21];
    constexpr int I_OUT = 16 * 32, I_G = 16 * 16 * 16, I_D = 16 * 8 * 32, I_PG = 16 * 32, I_PP = 4 * 32;
    constexpr int NITEMS = I_OUT + 2 * I_G + I_D + I_PG + I_PP;
    for (int it = widx; it < NITEMS; it += nw) {
        int r = it;
        if (r < I_OUT) { const int kb = r / 32, nb = r % 32; transpose_item(w_out, 1024, 64 * kb, 32 * nb, (bf16*)(ws + WS_WOUT) + (size_t)(32 * nb) * 1024, 1024, scr, lane_); continue; } r -= I_OUT;
        if (r < 2 * I_G) { const int up = r >= I_G; if (up) r -= I_G; const int e = r / 256, q = r % 256, kb = q / 16, nb = q % 16, n0 = 32 * nb;
            const size_t drow = (size_t)e * 1024 + 256 * (n0 / 128) + (n0 % 128) + (up ? 128 : 0);
            transpose_item((up ? w_eu : w_eg) + (size_t)e * 1024 * 512, 512, 64 * kb, n0, (bf16*)(ws + WS_WGU) + drow * 1024, 1024, scr, lane_); continue; } r -= 2 * I_G;
        if (r < I_D) { const int e = r / 256, q = r % 256, kb = q / 32, nb = q % 32;
            transpose_item(w_ed + (size_t)e * 512 * 1024, 1024, 64 * kb, 32 * nb, (bf16*)(ws + WS_WD) + ((size_t)e * 1024 + 32 * nb) * 512, 512, scr, lane_); continue; } r -= I_D;
        if (r < I_PG) { const int kb = r / 32, nb = r % 32; transpose_item(w_pg, 1024, 64 * kb, 32 * nb, (bf16*)(ws + WS_WPG) + (size_t)(32 * nb) * 1024, 1024, scr, lane_); continue; } r -= I_PG;
        { const int kb = r / 32, nb = r % 32; transpose_item(w_pp, 1024, 64 * kb, 32 * nb, (bf16*)(ws + WS_WPP) + (size_t)(32 * nb) * 256, 256, scr, lane_); }
    }
}

__device__ __forceinline__ void p5_group_norm(const Frame& F) {
    int tid = threadIdx.x; asm volatile("" : "+v"(tid)); const int lane = tid & 63;
    const KArgs ka = kargs();
    bf16* Y = (bf16*)(F.ws + WS_Y); const float* ga = (const float*)ka->in[11]; const float* gb = (const float*)ka->in[12];
    for (int m = F.gw; m < T; m += F.NGW) {
        v4u* yr = (v4u*)(Y + (size_t)m * 1024) + lane;
#pragma unroll
        for (int half = 0; half < 2; ++half) { const v4u w = yr[64 * half]; float f[8];
            f[0] = bf2f(w.x & 0xffff); f[1] = bf2f(w.x >> 16); f[2] = bf2f(w.y & 0xffff); f[3] = bf2f(w.y >> 16); f[4] = bf2f(w.z & 0xffff); f[5] = bf2f(w.z >> 16); f[6] = bf2f(w.w & 0xffff); f[7] = bf2f(w.w >> 16);
            float s = 0.f;
#pragma unroll
            for (int j = 0; j < 8; ++j) s += f[j] * f[j];
            const float rstd = 1.0f / sqrtf(wave_sum(s) * (1.0f / 512) + EPS);
            const float* g = (half ? gb : ga) + 8 * lane; const f32x4 g0 = *(const f32x4*)g, g1 = *(const f32x4*)(g + 4);
            v4u o; o.x = pk2(f[0] * rstd * g0.x, f[1] * rstd * g0.y); o.y = pk2(f[2] * rstd * g0.z, f[3] * rstd * g0.w); o.z = pk2(f[4] * rstd * g1.x, f[5] * rstd * g1.y); o.w = pk2(f[6] * rstd * g1.z, f[7] * rstd * g1.w);
            yr[64 * half] = o; }
    }
}

#define BFLY(a, N, BIT) do { const bool up_ = (lane & (BIT)) != 0; _Pragma("unroll") for (int j_ = 0; j_ < (N); ++j_) { const float keep_ = up_ ? a[j_ + (N)] : a[j_], send_ = up_ ? a[j_] : a[j_ + (N)]; a[j_] = keep_ + __shfl_xor(send_, (BIT)); } } while (0)
__device__ __forceinline__ void p7_ffn_norm_router(const Frame& F) {
    int tid = threadIdx.x; asm volatile("" : "+v"(tid)); const int lane = tid & 63;
    const KArgs ka = kargs();
    const float* x1 = ka->out; const float* g = (const float*)ka->in[14]; const float* w_router = (const float*)ka->in[15]; bf16* H = (bf16*)(F.ws + WS_HB); float* AFF = (float*)(F.ws + WS_AFF);
    const float* p = (const float*)ka->in[1]; bf16* PB = (bf16*)(F.ws + WS_PB);
    f32x4* W4 = (f32x4*)F.lds;
    for (int idx = tid; idx < 16 * 4 * 64; idx += 512) { const int l = idx & 63, i = (idx >> 6) & 3, e = idx >> 8; f32x4 w;
#pragma unroll
        for (int j = 0; j < 4; ++j) { const int k = 4 * l + 256 * j + i; w[j] = g[k] * w_router[(size_t)k * 16 + e]; }
        W4[idx] = w; }
    __syncthreads();
    f32x4 gg[4];
#pragma unroll
    for (int j = 0; j < 4; ++j) gg[j] = ((const f32x4*)g)[lane + 64 * j];
    for (int m0 = F.gw * 4; m0 < T; m0 += F.NGW * 4) {
        f32x4 v[4][4]; float ss[4];
#pragma unroll
        for (int r = 0; r < 4; ++r) { const f32x4* xr = (const f32x4*)(x1 + (size_t)(m0 + r) * DM) + lane; float s = 0.f;
#pragma unroll
            for (int j = 0; j < 4; ++j) { v[r][j] = xr[64 * j]; s += (v[r][j].x * v[r][j].x + v[r][j].y * v[r][j].y) + (v[r][j].z * v[r][j].z + v[r][j].w * v[r][j].w); }
            ss[r] = s; }
        float a[64];
#pragma unroll
        for (int e = 0; e < 16; ++e) { float acc[4] = {0.f, 0.f, 0.f, 0.f};
#pragma unroll
            for (int i = 0; i < 4; ++i) { const f32x4 w = W4[(e * 4 + i) * 64 + lane];
#pragma unroll
                for (int r = 0; r < 4; ++r) acc[r] += (v[r][0][i] * w[0] + v[r][1][i] * w[1]) + (v[r][2][i] * w[2] + v[r][3][i] * w[3]); }
#pragma unroll
            for (int r = 0; r < 4; ++r) a[r * 16 + e] = acc[r];
            if (e & 1) asm volatile("" ::: "memory"); }
        BFLY(a, 32, 32); BFLY(a, 16, 16); BFLY(a, 8, 8); BFLY(a, 4, 4); BFLY(a, 2, 2); BFLY(a, 1, 1);
        BFLY(ss, 2, 32); BFLY(ss, 1, 16);
        float sq = ss[0]; sq += __shfl_xor(sq, 8); sq += __shfl_xor(sq, 4); sq += __shfl_xor(sq, 2); sq += __shfl_xor(sq, 1);
        const float rstd = 1.0f / sqrtf(sq * (1.0f / DM) + EPS);
        const float logit = a[0] * rstd;
        float mx = logit; mx = fmaxf(mx, __shfl_xor(mx, 8)); mx = fmaxf(mx, __shfl_xor(mx, 4)); mx = fmaxf(mx, __shfl_xor(mx, 2)); mx = fmaxf(mx, __shfl_xor(mx, 1));
        const float ex = __expf(logit - mx); float den = ex; den += __shfl_xor(den, 8); den += __shfl_xor(den, 4); den += __shfl_xor(den, 2); den += __shfl_xor(den, 1);
        { const int m = m0 + (lane >> 4); AFF[((size_t)(m >> 11) * 16 + (lane & 15)) * SEQ + (m & (SEQ - 1))] = ex / den; }
#pragma unroll
        for (int r = 0; r < 4; ++r) { const float rs = __uint_as_float((unsigned)__builtin_amdgcn_readlane((int)__float_as_uint(rstd), 16 * r)); unsigned long long* o8 = (unsigned long long*)(H + (size_t)(m0 + r) * DM) + lane;
#pragma unroll
            for (int j = 0; j < 4; ++j) { const f32x4 h = v[r][j] * rs * gg[j]; o8[64 * j] = (unsigned long long)pk2(h.x, h.y) | ((unsigned long long)pk2(h.z, h.w) << 32); }
            const f32x4 pv = ((const f32x4*)(p + (size_t)(m0 + r) * PLE))[lane];
            ((unsigned long long*)(PB + (size_t)(m0 + r) * PLE))[lane] = (unsigned long long)pk2(pv.x, pv.y) | ((unsigned long long)pk2(pv.z, pv.w) << 32); }
    }
    __syncthreads();
}

__device__ __forceinline__ void p8_topk(const Frame& F, int widx, int nwg) {
    int tid = threadIdx.x; asm volatile("" : "+v"(tid)); const int lane = tid & 63, wave = tid >> 6;
    unsigned char* ws = F.ws; const float* AFF = (const float*)(ws + WS_AFF); int* INV = (int*)(ws + WS_INV); int* SEL = (int*)(ws + WS_SEL); float* VAL = (float*)(ws + WS_VAL);
    unsigned long long* keys = (unsigned long long*)F.lds;
    for (int task = widx; task < NBE; task += nwg) {
        const int b = task >> 4, e = task & 15;
        for (int i = tid; i < SEQ; i += 512) keys[i] = ((unsigned long long)__float_as_uint(AFF[(size_t)task * SEQ + i]) << 32) | (unsigned)(SEQ - 1 - i);
        __syncthreads();
        for (int k = 2; k <= SEQ; k <<= 1) {
            int j = k >> 1;
            if (j >= 256) {
                for (; j >= 256; j >>= 1) {
                    for (int p = tid; p < SEQ / 2; p += 512) { const int i = ((p & ~(j - 1)) << 1) | (p & (j - 1)), l = i | j; const bool desc = (i & k) == 0;
                        const unsigned long long x = keys[i], y = keys[l]; if ((x < y) == desc) { keys[i] = y; keys[l] = x; } }
                    __syncthreads();
                }
            }
            for (; j > 0; j >>= 1) {
#pragma unroll
                for (int q = lane; q < 128; q += 64) { const int li = ((q & ~(j - 1)) << 1) | (q & (j - 1)), i = wave * 256 + li, l = i | j; const bool desc = (i & k) == 0;
                    const unsigned long long x = keys[i], y = keys[l]; if ((x < y) == desc) { keys[i] = y; keys[l] = x; } }
                asm volatile("s_waitcnt lgkmcnt(0)" ::: "memory");
            }
            if (k >= 256) __syncthreads();
        }
        __syncthreads();
        for (int c = tid; c < SEQ; c += 512) { const unsigned long long kk = keys[c]; const int idx = SEQ - 1 - (int)(unsigned)(kk & 0xffffffffu);
            if (c < CAP) { SEL[task * CAP + c] = idx; VAL[task * CAP + c] = __uint_as_float((unsigned)(kk >> 32)); INV[((size_t)b * SEQ + idx) * 16 + e] = c; }
            else INV[((size_t)b * SEQ + idx) * 16 + e] = -1; }
        __syncthreads();
    }
}

__device__ __forceinline__ void p11_row(const bf16* OB, int b, int inv, unsigned mask, int lane, f32x4 (&v)[4]) {
    while (mask) {
        v2u w[4][4]; int n = 0;
#pragma unroll
        for (int q = 0; q < 4; ++q) if (mask) { const int e = __builtin_ctz(mask); mask &= mask - 1; const int c = __builtin_amdgcn_readlane(inv, e);
            const v2u* orow = (const v2u*)(OB + ((size_t)(b * 16 + e) * CAP + c) * DM) + lane;
#pragma unroll
            for (int j = 0; j < 4; ++j) w[q][j] = orow[64 * j];
            n = q + 1; }
#pragma unroll
        for (int q = 0; q < 4; ++q) if (q < n) {
#pragma unroll
            for (int j = 0; j < 4; ++j) { v[j].x += bf2f(w[q][j].x & 0xffff); v[j].y += bf2f(w[q][j].x >> 16); v[j].z += bf2f(w[q][j].y & 0xffff); v[j].w += bf2f(w[q][j].y >> 16); } }
    }
}
__device__ __forceinline__ void p11_combine_norm(const Frame& F) {
    int tid = threadIdx.x; asm volatile("" : "+v"(tid)); const int lane = tid & 63;
    const KArgs ka = kargs();
    unsigned char* ws = F.ws; float* xo = ka->out; const int* INV = (const int*)(ws + WS_INV); const bf16* OB = (const bf16*)(ws + WS_OB); bf16* H = (bf16*)(ws + WS_HB);
    const float* g = (const float*)ka->in[19];
    f32x4 gg[4];
#pragma unroll
    for (int j = 0; j < 4; ++j) gg[j] = ((const f32x4*)g)[lane + 64 * j];
    for (int m0 = F.gw * 2; m0 < T; m0 += F.NGW * 2) {
        f32x4 va[4], vb[4];
        f32x4* xa = (f32x4*)(xo + (size_t)m0 * DM) + lane; f32x4* xb = xa + DM / 4;
        const int inva = INV[(size_t)m0 * 16 + (lane & 15)], invb = INV[(size_t)(m0 + 1) * 16 + (lane & 15)];
#pragma unroll
        for (int j = 0; j < 4; ++j) { va[j] = xa[64 * j]; vb[j] = xb[64 * j]; }
        const unsigned ma = (unsigned)(__ballot(inva >= 0) & 0xffffull), mb = (unsigned)(__ballot(invb >= 0) & 0xffffull);
        p11_row(OB, m0 >> 11, inva, ma, lane, va); p11_row(OB, m0 >> 11, invb, mb, lane, vb);
        float sa = 0.f, sb = 0.f;
#pragma unroll
        for (int j = 0; j < 4; ++j) { xa[64 * j] = va[j]; xb[64 * j] = vb[j]; sa += (va[j].x * va[j].x + va[j].y * va[j].y) + (va[j].z * va[j].z + va[j].w * va[j].w); sb += (vb[j].x * vb[j].x + vb[j].y * vb[j].y) + (vb[j].z * vb[j].z + vb[j].w * vb[j].w); }
        const float ra = 1.0f / sqrtf(wave_sum(sa) * (1.0f / DM) + EPS), rb = 1.0f / sqrtf(wave_sum(sb) * (1.0f / DM) + EPS);
        unsigned long long* oa = (unsigned long long*)(H + (size_t)m0 * DM) + lane; unsigned long long* ob = oa + DM / 4;
#pragma unroll
        for (int j = 0; j < 4; ++j) { const f32x4 ha = va[j] * ra * gg[j], hb = vb[j] * rb * gg[j];
            oa[64 * j] = (unsigned long long)pk2(ha.x, ha.y) | ((unsigned long long)pk2(ha.z, ha.w) << 32); ob[64 * j] = (unsigned long long)pk2(hb.x, hb.y) | ((unsigned long long)pk2(hb.z, hb.w) << 32); }
    }
}

__device__ __forceinline__ void p13_final_norm(const Frame& F) {
    int tid = threadIdx.x; asm volatile("" : "+v"(tid)); const int lane = tid & 63;
    const KArgs ka = kargs();
    float* xo = ka->out; const float* g = (const float*)ka->in[22];
    for (int m = F.gw; m < T; m += F.NGW) {
        f32x4* xr = (f32x4*)(xo + (size_t)m * DM) + lane; f32x4 v[4]; float s = 0.f;
#pragma unroll
        for (int j = 0; j < 4; ++j) { v[j] = xr[64 * j]; s += (v[j].x * v[j].x + v[j].y * v[j].y) + (v[j].z * v[j].z + v[j].w * v[j].w); }
        const float rstd = 1.0f / sqrtf(wave_sum(s) * (1.0f / DM) + EPS);
#pragma unroll
        for (int j = 0; j < 4; ++j) { const f32x4 gg = ((const f32x4*)g)[lane + 64 * j]; xr[64 * j] = v[j] * rstd * gg; }
    }
}

#ifndef PHMASK
#define PHMASK 0x7ffff
#endif
#ifndef DBLMASK
#define DBLMASK 0
#endif
#ifdef STAMP_K
#define STAMP(i) do { if ((i) == STAMP_K - 1) ts0 = __builtin_amdgcn_s_memrealtime(); if ((i) == STAMP_K) ts1 = __builtin_amdgcn_s_memrealtime(); } while (0)
#else
#define STAMP(i) do { } while (0)
#endif
#define REP(bit) for (int rep_ = 0; rep_ < ((DBLMASK & (bit)) ? 2 : 1); ++rep_)
__global__ void __launch_bounds__(NWAVES * 64, 2) fwd_kernel(Args args) {
    extern __shared__ __attribute__((aligned(16))) unsigned char lds[];
    Frame F;
    F.lds = (char*)lds; F.tid = threadIdx.x; F.lane = F.tid & 63; F.wave = __builtin_amdgcn_readfirstlane(F.tid >> 6);
    F.G = gridDim.x; { const int bx = blockIdx.x; F.vcu = (F.G % 8 == 0) ? (bx % 8) * (F.G / 8) + bx / 8 : bx; }
    F.gw = F.vcu * NWAVES + F.wave; F.NGW = F.G * NWAVES; F.ws = args.ws;
    unsigned char* ws = args.ws;
    volatile LAS unsigned* MISC = (volatile LAS unsigned*)((LAS unsigned char*)lds + MISC_OFF);
    if (F.tid < 16) MISC[F.tid] = 0u;
    __syncthreads();
    XcdBarrier bar = xcd_barrier_post((unsigned*)(ws + WS_CTL) + CW_BAR, MISC + 8);
    PG8_LAS unsigned char* ring = (PG8_LAS unsigned char*)lds;
    const int G = F.G, bx = (int)blockIdx.x;

#ifdef STAMP_K
    unsigned long long ts0 = __builtin_amdgcn_s_memrealtime(), ts1 = 0;
#endif
    REP(1) if (PHMASK & 1) p0_prologue(F);
    xcd_barrier(bar); STAMP(0);
    REP(2) if (PHMASK & 2) { pg8::Gemm g{(const bf16*)(ws + WS_HB), (const bf16*)(ws + WS_WIN), T, IN_PAD, DM}; pg8::StaticOrder S; S.init(T, IN_PAD, G, bx);
      pg8::EpiZ E{ws};
      pg8::gemm_phase<pg8::EpiZ, pg8::StaticOrder, true, false>(ring, g, S, E);
      const int nu = S.nwg, rem = nu % G;
      if (rem == 0) convert_late_weights(F, F.gw, F.NGW); else if (bx >= rem) convert_late_weights(F, (bx - rem) * NWAVES + F.wave, (G - rem) * NWAVES); }
    xcd_barrier(bar); STAMP(1);
    REP(8) if (PHMASK & 8) { pg8::Gemm g{(const bf16*)(ws + WS_CQN), (const bf16*)(ws + WS_WUQ), T, 768, 256}; pg8::StaticOrder S; S.init(T, 768, G, bx);
      pg8::EpiBf<768> E{(bf16*)(ws + WS_QB)};
      pg8::gemm_phase<pg8::EpiBf<768>, pg8::StaticOrder, true, false>(ring, g, S, E); }
    REP(0x20000) if (PHMASK & 0x20000) { pg8::Gemm g{(const bf16*)(ws + WS_CKVN), (const bf16*)(ws + WS_WUKV), T, 1024, 256}; pg8::StaticOrder S; S.init(T, 1024, G, bx);
      pg8::EpiBf<1024> E{(bf16*)(ws + WS_KVB)};
      pg8::gemm_phase<pg8::EpiBf<1024>, pg8::StaticOrder, true, false>(ring, g, S, E); }
    xcd_barrier(bar); STAMP(2);
    if (PHMASK & 16) { const bf16* QB = (const bf16*)(ws + WS_QB); const bf16* KVB = (const bf16*)(ws + WS_KVB); const bf16* KR = (const bf16*)(ws + WS_KR); bf16* Y = (bf16*)(ws + WS_Y);
      REP(16) for (int u = F.vcu; u < 512; u += G) { const int qb = u & 7, bh = u >> 3;
          att::mla::unit(bh >> 3, bh & 7, qb, QB, KVB, KR, (const float*)(ws + WS_COS), (const float*)(ws + WS_SIN), Y, (char*)lds); }
      REP(0x10000) if (PHMASK & 0x10000) for (int u = F.vcu; u < 512; u += G) { const int qb = u & 7, bh = u >> 3;
          att::wnd::unit(bh >> 3, bh & 7, qb, (const bf16*)(ws + WS_QA), (const bf16*)(ws + WS_KVA), (const float*)kargs()->in[3], (const float*)kargs()->in[6], Y, (char*)lds); } }
    xcd_barrier(bar); STAMP(3);
    if (PHMASK & 32) p5_group_norm(F);
    xcd_barrier(bar); STAMP(4);
    REP(64) if (PHMASK & 64) { pg8::Gemm g{(const bf16*)(ws + WS_Y), (const bf16*)(ws + WS_WOUT), T, DM, DM}; pg8::StaticOrder S; S.init(T, DM, G, bx);
      const KArgs ka = kargs(); pg8::EpiRes E{(const float*)ka->in[0], ka->out};
      pg8::gemm_phase<pg8::EpiRes, pg8::StaticOrder, true, false>(ring, g, S, E); }
    xcd_barrier(bar); STAMP(5);
    REP(128) if (PHMASK & 128) p7_ffn_norm_router(F);
    xcd_barrier(bar); STAMP(6);
    if (PHMASK & 256) { const int nsort = G / 2;
      if (bx < nsort) p8_topk(F, bx, nsort);
      else { pg8::Gemm g{(const bf16*)(ws + WS_PB), (const bf16*)(ws + WS_WPP), T, DM, PLE}; pg8::StaticOrder S; S.init(T, DM, G - nsort, bx - nsort);
        pg8::EpiBf<1024> E{(bf16*)(ws + WS_PROJ)};
        pg8::gemm_phase<pg8::EpiBf<1024>, pg8::StaticOrder, true, false>(ring, g, S, E); } }
    xcd_barrier(bar); STAMP(7);
    REP(512) if (PHMASK & 512) { pg8::Gemm g{(const bf16*)(ws + WS_HB), (const bf16*)(ws + WS_WGU), NBE * CAP, 1024, DM}; pg8::StaticOrder S; S.init(NBE * CAP, 1024, G, bx); S.bexp = 16;
      PG8_LAS int* gtab = (PG8_LAS int*)((PG8_LAS unsigned char*)lds + XTRA_OFF); const int* SEL = (const int*)(ws + WS_SEL);
      { pg8::Unit u; for (int i = 0; i < 15 && S.next(i, u); ++i) if (F.tid < 256) gtab[i * 256 + F.tid] = (u.pm >> 4) * SEQ + SEL[u.pm * CAP + F.tid]; }
      __syncthreads();
      pg8::EpiSwiGLU E{(bf16*)(ws + WS_ACT)};
      pg8::gemm_phase<pg8::EpiSwiGLU, pg8::StaticOrder, true, true>(ring, g, S, E, gtab); }
    xcd_barrier(bar); STAMP(8);
    REP(1024) if (PHMASK & 1024) { pg8::Gemm g{(const bf16*)(ws + WS_ACT), (const bf16*)(ws + WS_WD), NBE * CAP, 1024, FF}; pg8::StaticOrder S; S.init(NBE * CAP, 1024, G, bx); S.bexp = 16;
      pg8::EpiDown E{(bf16*)(ws + WS_OB), (const float*)(ws + WS_VAL)};
      pg8::gemm_phase<pg8::EpiDown, pg8::StaticOrder, true, false>(ring, g, S, E); }
    xcd_barrier(bar); STAMP(9);
    if (PHMASK & 2048) p11_combine_norm(F);
    xcd_barrier(bar); STAMP(10);
    if (PHMASK & 0x40000) { pg8::Gemm g{(const bf16*)(ws + WS_HB), (const bf16*)(ws + WS_WPG), T, DM, DM}; pg8::StaticOrder S; S.init(T, DM, G, bx);
      pg8::EpiPle E{kargs()->out, (const bf16*)(ws + WS_PROJ)};
      pg8::gemm_phase<pg8::EpiPle, pg8::StaticOrder, true, false>(ring, g, S, E); }
    xcd_barrier(bar); STAMP(11);
    if (PHMASK & 8192) p13_final_norm(F);
#ifdef STAMP_K
    { const unsigned long long te = __builtin_amdgcn_s_memrealtime(); if (STAMP_K == 12) ts1 = te;
      if (blockIdx.x == 0) { const unsigned long long want = (ts1 - ts0) * STAMP_MULT; while (__builtin_amdgcn_s_memrealtime() - te < want) __builtin_amdgcn_s_sleep(8); } }
#endif
}

extern "C" void kernel_launch(void* const* d_in, const int* in_sizes, int n_in, void* d_out, int out_size, void* d_ws, size_t ws_size, hipStream_t stream) {
    static int grid = 0;
    if (grid == 0) {
        if (n_in != 23 || in_sizes[0] != T * DM || out_size != T * DM || ws_size < WS_END) { fprintf(stderr, "kernel_launch: unexpected shapes: n_in %d in0 %d out %d ws %zu (need %zu)\n", n_in, n_in > 0 ? in_sizes[0] : -1, out_size, ws_size, (size_t)WS_END); grid = -1; return; }
        int dev = 0, cus = 0, per_cu = 0;
        if (hipGetDevice(&dev) != hipSuccess || hipDeviceGetAttribute(&cus, hipDeviceAttributeMultiprocessorCount, dev) != hipSuccess) { fprintf(stderr, "kernel_launch: device query failed\n"); grid = -1; return; }
        if (hipFuncSetAttribute((const void*)fwd_kernel, hipFuncAttributeMaxDynamicSharedMemorySize, LDS_BYTES) != hipSuccess) { fprintf(stderr, "kernel_launch: hipFuncSetAttribute failed\n"); grid = -1; return; }
        if (hipOccupancyMaxActiveBlocksPerMultiprocessor(&per_cu, (const void*)fwd_kernel, NWAVES * 64, LDS_BYTES) != hipSuccess || per_cu < 1) { fprintf(stderr, "kernel_launch: occupancy query says %d workgroups per CU\n", per_cu); (void)hipGetLastError(); }
        grid = cus;
    }
    if (grid < 0) return;
    if (hipMemsetAsync((char*)d_ws + WS_CTL, 0, CTL_ZERO_BYTES, stream) != hipSuccess) { fprintf(stderr, "kernel_launch: hipMemsetAsync failed\n"); return; }
    Args a{};
    for (int i = 0; i < 23; ++i) a.in[i] = d_in[i];
    a.out = (float*)d_out; a.ws = (unsigned char*)d_ws;
    hipLaunchKernelGGL(fwd_kernel, dim3(grid), dim3(NWAVES * 64), LDS_BYTES, stream, a);
    const hipError_t le = hipPeekAtLastError();
    if (le != hipSuccess) fprintf(stderr, "kernel_launch: launch failed: %s\n", hipGetErrorName(le));
}
```

```cpp
#include <hip/hip_runtime.h>
#include <hip/hip_bf16.h>
#include <cstdio>
#include <cstdint>

constexpr int BATCH = 8, SEQ = 2048, DM = 1024, T = BATCH * SEQ;
constexpr int IN_COLS = 1184, IN_PAD = 1280;
constexpr int NE = 16, FF = 512, CAP = 256, NBE = BATCH * NE;
constexpr int PLE = 256;
constexpr float EPS = 1e-6f;
constexpr float LOG2E = 1.4426950408889634f;

struct Args { const void* in[23]; float* out; unsigned char* ws; };
typedef const __attribute__((address_space(4))) Args* KArgs;
__device__ __forceinline__ KArgs kargs() { KArgs p = (KArgs)__builtin_amdgcn_kernarg_segment_ptr(); asm volatile("" : "+s"(p)); return p; }

constexpr size_t MiB = 1u << 20, KiB = 1u << 10;
constexpr size_t WS_CTL = 0, CTL_ZERO_BYTES = 64 * KiB;
constexpr size_t WS_WIN = 1 * MiB;
constexpr size_t WS_WUQ = WS_WIN + (size_t)IN_PAD * DM * 2;
constexpr size_t WS_WUKV = WS_WUQ + 768 * 256 * 2;
constexpr size_t WS_WOUT = WS_WUKV + 1024 * 256 * 2;
constexpr size_t WS_WPG = WS_WOUT + 2 * MiB;
constexpr size_t WS_WPP = WS_WPG + 2 * MiB;
constexpr size_t WS_WGU = 9 * MiB;
constexpr size_t WS_WD = WS_WGU + 32 * MiB;
constexpr size_t WS_COS = WS_WD + 16 * MiB, WS_SIN = WS_COS + 1 * MiB;
constexpr size_t WS_AFF = WS_SIN + 1 * MiB;
constexpr size_t WS_INV = WS_AFF + 1 * MiB;
constexpr size_t WS_SEL = WS_INV + 1 * MiB;
constexpr size_t WS_VAL = WS_SEL + 128 * KiB;
constexpr size_t WS_HB = 62 * MiB;
constexpr size_t WS_Y = 94 * MiB;
constexpr size_t WS_R1 = 126 * MiB;
constexpr size_t WS_QA = WS_R1;
constexpr size_t WS_KVA = WS_QA + 16 * MiB;
constexpr size_t WS_CQN = WS_KVA + 8 * MiB;
constexpr size_t WS_CKVN = WS_CQN + 8 * MiB;
constexpr size_t WS_KR = WS_CKVN + 8 * MiB;
constexpr size_t WS_QB = WS_KR + 1 * MiB;
constexpr size_t WS_KVB = WS_QB + 24 * MiB;
constexpr size_t WS_ACT = WS_R1 + 64 * MiB;
constexpr size_t WS_OB = WS_R1;
constexpr size_t WS_PROJ = WS_R1 + 97 * MiB;
constexpr size_t WS_PB = WS_Y;
constexpr size_t WS_XCH = WS_VAL + 128 * KiB;
constexpr size_t WS_END = 255 * MiB;
static_assert(WS_WPP + 1024 * 256 * 2 <= WS_WGU && WS_XCH + 512 * KiB <= WS_HB && WS_KVB + 32 * MiB <= WS_PROJ && WS_ACT + 32 * MiB <= WS_PROJ && WS_PROJ + 32 * MiB <= WS_END, "d_ws map");
constexpr int CW_BAR = 1024;
constexpr int CW_TMO = 0;
constexpr int CW_PANEL = 8192;

constexpr int RING_BYTES = 131072;
constexpr int MISC_OFF = RING_BYTES;
constexpr int XTRA_OFF = RING_BYTES + 256;
constexpr int LDS_BYTES = 147456;
constexpr int NWAVES = 8;


namespace pg8 {
#define PG8_LAS __attribute__((address_space(3)))
typedef unsigned short bf16_t;
typedef short bf16x8 __attribute__((ext_vector_type(8)));
typedef float f32x4 __attribute__((ext_vector_type(4)));
typedef unsigned u32x4 __attribute__((ext_vector_type(4)));
constexpr int BM = 256, BK = 64, HALF = 128, HTB = HALF * BK * 2  , STAGE_BYTES = 8 * HTB, NXCD = 8, WGM = 8;

__host__ __device__ __forceinline__ int lds_byte(int r, int c) { const int st = (r >> 4) * 2 + (c >> 5), rr = r & 15, cc = c & 31, ob = rr * 64 + cc * 2; return st * 1024 + (ob ^ (((ob >> 9) & 1) << 5)); }
__host__ __device__ __forceinline__ void stage_rc(int b, int& R, int& C) { const int st = b / 1024, sb = b % 1024, swz = sb ^ (((sb >> 9) & 1) << 5); R = (st >> 1) * 16 + swz / 64; C = (st & 1) * 32 + (swz % 64) / 2; }
__host__ __device__ __forceinline__ int perm32(int rho) { const int n = rho >> 4, i = rho & 15; return 8 * (i >> 2) + 4 * n + (i & 3); }

struct Unit { int pm, pn; };
struct Gemm { const bf16_t* A; const bf16_t* Bt; int M, N, K; };

struct StaticOrder {
    int nM, nN, nwg, G, c, bexp;
    __host__ __device__ void init(int M, int N, int G_, int c_) { nM = M / BM; nN = N / BM; nwg = nM * nN; G = G_; c = c_; bexp = 0; }
    __host__ __device__ bool next(int i, Unit& u) const {
        const long L = (long)i * G + c; if (L >= nwg) return false;
        int wgid = (int)L; { const int q = nwg / NXCD, r = nwg % NXCD, xcd = wgid % NXCD, off = wgid / NXCD; wgid = (xcd < r ? xcd * (q + 1) : r * (q + 1) + (xcd - r) * q) + off; }
        const int nig = WGM * nN, gid = wgid / nig, fm = gid * WGM, gsz = (nM - fm) < WGM ? (nM - fm) : WGM;
        u.pm = fm + ((wgid % nig) % gsz); u.pn = (wgid % nig) / gsz; return true;
    }
    __device__ __forceinline__ int btile(const Unit& u) const { return bexp ? (u.pm & (bexp - 1)) * nN + u.pn : u.pn; }
    __device__ __forceinline__ void a_ready(const Unit&) const {}
    __device__ __forceinline__ void done(const Unit&) const {}
};


__device__ __forceinline__ unsigned cvt_pk_bf16(float lo, float hi) { unsigned r; asm volatile("v_cvt_pk_bf16_f32 %0, %1, %2" : "=v"(r) : "v"(lo), "v"(hi)); return r; }
#define EPI_DEFAULTS struct State {}; static constexpr bool HAS_MID = false, AFTER_DRAIN = false; static constexpr int MID_T = 0; \
    __device__ __forceinline__ void pre(State&, const Unit&, int, int, int, int) const {} \
    __device__ __forceinline__ void mid(State&, f32x4 (&)[2][2][4][2], const Unit&, int, int, int, int) const {}
__device__ __forceinline__ u32x4 pack8(const f32x4 v0, const f32x4 v1) { u32x4 w; w.x = cvt_pk_bf16(v0[0], v0[1]); w.y = cvt_pk_bf16(v0[2], v0[3]); w.z = cvt_pk_bf16(v1[0], v1[1]); w.w = cvt_pk_bf16(v1[2], v1[3]); return w; }
__device__ __forceinline__ float bflo(unsigned w) { return __builtin_bit_cast(float, w << 16); }
__device__ __forceinline__ float bfhi(unsigned w) { return __builtin_bit_cast(float, w & 0xffff0000u); }

struct EpiZ {
    static constexpr bool PERM = true; EPI_DEFAULTS
    unsigned char* ws;
    __device__ __forceinline__ void operator()(State&, const f32x4 (&acc)[2][2][4][2], const Unit& u, int wr, int wc, int fr, int fq) const {
        const int row0 = u.pm * BM + wr * 64 + fr, c8 = wc * 32 + 8 * fq;
        bf16_t* QA = (bf16_t*)(ws + WS_QA); bf16_t* KVA = (bf16_t*)(ws + WS_KVA);
        if (u.pn < 3) {
#pragma unroll
            for (int ai = 0; ai < 2; ++ai)
#pragma unroll
                for (int m = 0; m < 4; ++m) { const size_t row = (size_t)(row0 + ai * HALF + m * 16);
#pragma unroll
                    for (int bj = 0; bj < 2; ++bj) { const int col = bj * HALF + c8; const f32x4 v0 = acc[ai][bj][m][0], v1 = acc[ai][bj][m][1];
                        if (u.pn < 2) *(u32x4*)(QA + row * 512 + u.pn * 256 + col) = pack8(v0, v1);
                        else *(u32x4*)(KVA + row * 256 + col) = pack8(v0, v1); } }
            return;
        }
        const bool cq = (u.pn == 3);
        bf16_t* CQN = (bf16_t*)(ws + WS_CQN); bf16_t* CKVN = (bf16_t*)(ws + WS_CKVN); bf16_t* KR = (bf16_t*)(ws + WS_KR); const float* COS = (const float*)(ws + WS_COS); const float* SIN = (const float*)(ws + WS_SIN);
        const KArgs ka = kargs(); const float* g_cq = (const float*)ka->in[7]; const float* g_ckv = (const float*)ka->in[8];
        PG8_LAS float* P = (PG8_LAS float*)(XTRA_OFF);
#pragma unroll
        for (int ai = 0; ai < 2; ++ai)
#pragma unroll
            for (int m = 0; m < 4; ++m) { float s = 0.f;
#pragma unroll
                for (int bj = 0; bj < 2; ++bj) { if (bj == 1 && !cq) continue;
#pragma unroll
                    for (int n = 0; n < 2; ++n) { const f32x4 x = acc[ai][bj][m][n]; s += (x[0] * x[0] + x[1] * x[1]) + (x[2] * x[2] + x[3] * x[3]); } }
                s += __shfl_xor(s, 16); s += __shfl_xor(s, 32);
                if (fq == 0) P[(ai * HALF + wr * 64 + m * 16 + fr) * 4 + wc] = s; }
        asm volatile("s_waitcnt lgkmcnt(0)" ::: "memory"); __builtin_amdgcn_s_barrier(); asm volatile("" ::: "memory");
        const float inv_n = cq ? (1.0f / 256.0f) : (1.0f / 128.0f);
        f32x4 gv[2][2];
#pragma unroll
        for (int bj = 0; bj < 2; ++bj)
#pragma unroll
            for (int n = 0; n < 2; ++n) gv[bj][n] = cq ? *(const f32x4*)(g_cq + bj * HALF + c8 + 4 * n) : *(const f32x4*)(g_ckv + c8 + 4 * n);
#pragma unroll
        for (int ai = 0; ai < 2; ++ai)
#pragma unroll
            for (int m = 0; m < 4; ++m) { const int rl = ai * HALF + wr * 64 + m * 16 + fr; const size_t row = (size_t)(u.pm * BM + rl);
                const f32x4 pp = *(const PG8_LAS f32x4*)(P + rl * 4); const float rstd = 1.0f / sqrtf(((pp[0] + pp[1]) + (pp[2] + pp[3])) * inv_n + 1e-6f);
                if (cq) {
#pragma unroll
                    for (int bj = 0; bj < 2; ++bj) *(u32x4*)(CQN + row * 256 + bj * HALF + c8) = pack8(acc[ai][bj][m][0] * rstd * gv[bj][0], acc[ai][bj][m][1] * rstd * gv[bj][1]);
                } else {
                    *(u32x4*)(CKVN + row * 256 + c8) = pack8(acc[ai][0][m][0] * rstd * gv[0][0], acc[ai][0][m][1] * rstd * gv[0][1]);
                    *(u32x4*)(CKVN + row * 256 + HALF + c8) = (u32x4){0u, 0u, 0u, 0u};
                    if (wc == 0) { f32x4 mine0 = acc[ai][1][m][0], mine1 = acc[ai][1][m][1], oth0, oth1;
#pragma unroll
                        for (int i = 0; i < 4; ++i) { oth0[i] = __shfl_xor(mine0[i], 32); oth1[i] = __shfl_xor(mine1[i], 32); }
                        const int j0 = 8 * (fq & 1); const f32x4 cs0 = *(const f32x4*)(COS + row * 16 + j0), cs1 = *(const f32x4*)(COS + row * 16 + j0 + 4), sn0 = *(const f32x4*)(SIN + row * 16 + j0), sn1 = *(const f32x4*)(SIN + row * 16 + j0 + 4);
                        f32x4 r0, r1;
                        if (fq < 2) { r0 = mine0 * cs0 - oth0 * sn0; r1 = mine1 * cs1 - oth1 * sn1; }
                        else { r0 = oth0 * sn0 + mine0 * cs0; r1 = oth1 * sn1 + mine1 * cs1; }
                        *(u32x4*)(KR + row * 32 + 8 * fq) = pack8(r0, r1); } } }
    }
};
template <int ldc> struct EpiBf {
    static constexpr bool PERM = true; EPI_DEFAULTS
    bf16_t* O;
    __device__ __forceinline__ void operator()(State&, const f32x4 (&acc)[2][2][4][2], const Unit& u, int wr, int wc, int fr, int fq) const {
        const int row0 = u.pm * BM + wr * 64 + fr, c8 = u.pn * BM + wc * 32 + 8 * fq;
#pragma unroll
        for (int ai = 0; ai < 2; ++ai)
#pragma unroll
            for (int m = 0; m < 4; ++m) { bf16_t* rowp = O + (size_t)(row0 + ai * HALF + m * 16) * ldc + c8;
#pragma unroll
                for (int bj = 0; bj < 2; ++bj) *(u32x4*)(rowp + bj * HALF) = pack8(acc[ai][bj][m][0], acc[ai][bj][m][1]); }
    }
};
struct EpiRes {
    static constexpr bool PERM = false; EPI_DEFAULTS
    const float* base; float* out;
    __device__ __forceinline__ void operator()(State&, const f32x4 (&acc)[2][2][4][2], const Unit& u, int wr, int wc, int fr, int fq) const {
        const int row0 = u.pm * BM + wr * 64 + fr, c4 = u.pn * BM + wc * 32 + 4 * fq;
#pragma unroll
        for (int ai = 0; ai < 2; ++ai)
#pragma unroll
            for (int m = 0; m < 4; ++m) { const size_t off = (size_t)(row0 + ai * HALF + m * 16) * 1024 + c4;
#pragma unroll
                for (int bj = 0; bj < 2; ++bj)
#pragma unroll
                    for (int n = 0; n < 2; ++n) { const f32x4 b = *(const f32x4*)(base + off + bj * HALF + n * 16); *(f32x4*)(out + off + bj * HALF + n * 16) = b + acc[ai][bj][m][n]; } }
    }
};
struct EpiSwiGLU {
    static constexpr bool PERM = true; EPI_DEFAULTS
    bf16_t* ACT;
    __device__ __forceinline__ void operator()(State&, const f32x4 (&acc)[2][2][4][2], const Unit& u, int wr, int wc, int fr, int fq) const {
        const int row0 = u.pm * BM + wr * 64 + fr, c8 = u.pn * HALF + wc * 32 + 8 * fq;
#pragma unroll
        for (int ai = 0; ai < 2; ++ai)
#pragma unroll
            for (int m = 0; m < 4; ++m) { f32x4 r[2];
#pragma unroll
                for (int n = 0; n < 2; ++n)
#pragma unroll
                    for (int i = 0; i < 4; ++i) { const float g = acc[ai][0][m][n][i], up = acc[ai][1][m][n][i]; r[n][i] = g * __builtin_amdgcn_rcpf(1.0f + __expf(-g)) * up; }
                *(u32x4*)(ACT + (size_t)(row0 + ai * HALF + m * 16) * 512 + c8) = pack8(r[0], r[1]); }
    }
};
struct EpiDown {
    static constexpr bool PERM = true; EPI_DEFAULTS
    bf16_t* OB; const float* VAL;
    __device__ __forceinline__ void operator()(State&, const f32x4 (&acc)[2][2][4][2], const Unit& u, int wr, int wc, int fr, int fq) const {
        const int row0 = u.pm * BM + wr * 64 + fr, c8 = u.pn * BM + wc * 32 + 8 * fq;
#pragma unroll
        for (int ai = 0; ai < 2; ++ai)
#pragma unroll
            for (int m = 0; m < 4; ++m) { const int row = row0 + ai * HALF + m * 16; const float s = VAL[row]; bf16_t* rowp = OB + (size_t)row * 1024 + c8;
#pragma unroll
                for (int bj = 0; bj < 2; ++bj) *(u32x4*)(rowp + bj * HALF) = pack8(acc[ai][bj][m][0] * s, acc[ai][bj][m][1] * s); }
    }
};
struct EpiPle {
    static constexpr bool PERM = true; EPI_DEFAULTS
    float* out; const bf16_t* PROJ;
    __device__ __forceinline__ void operator()(State&, const f32x4 (&acc)[2][2][4][2], const Unit& u, int wr, int wc, int fr, int fq) const {
        const int row0 = u.pm * BM + wr * 64 + fr, c8 = u.pn * BM + wc * 32 + 8 * fq;
#pragma unroll
        for (int ai = 0; ai < 2; ++ai)
#pragma unroll
            for (int m = 0; m < 4; ++m) { const size_t off = (size_t)(row0 + ai * HALF + m * 16) * 1024 + c8;
#pragma unroll
                for (int bj = 0; bj < 2; ++bj) { float* op = out + off + bj * HALF; const u32x4 pw = *(const u32x4*)(PROJ + off + bj * HALF);
                    const f32x4 x0 = *(const f32x4*)op, x1 = *(const f32x4*)(op + 4); const f32x4 a0 = acc[ai][bj][m][0], a1 = acc[ai][bj][m][1];
                    f32x4 g0, g1;
#pragma unroll
                    for (int i = 0; i < 4; ++i) { g0[i] = __builtin_amdgcn_rcpf(1.0f + __expf(-a0[i])); g1[i] = __builtin_amdgcn_rcpf(1.0f + __expf(-a1[i])); }
                    f32x4 r0, r1;
                    r0[0] = x0[0] + g0[0] * bflo(pw.x); r0[1] = x0[1] + g0[1] * bfhi(pw.x); r0[2] = x0[2] + g0[2] * bflo(pw.y); r0[3] = x0[3] + g0[3] * bfhi(pw.y);
                    r1[0] = x1[0] + g1[0] * bflo(pw.z); r1[1] = x1[1] + g1[1] * bfhi(pw.z); r1[2] = x1[2] + g1[2] * bflo(pw.w); r1[3] = x1[3] + g1[3] * bfhi(pw.w);
                    *(f32x4*)op = r0; *(f32x4*)(op + 4) = r1; } }
    }
};

template <class Epi, class Sched, bool ALIGN_EPI = false, bool GATHER = false>
__device__ __forceinline__ void gemm_phase(PG8_LAS unsigned char* lds, const Gemm g, const Sched& S, const Epi& E, const PG8_LAS int* gtab = nullptr) {
    int tid_ = threadIdx.x; asm volatile("" : "+v"(tid_));
    const int tid = tid_, wid = __builtin_amdgcn_readfirstlane(tid >> 6), lane = tid & 63, wr = wid >> 2, wc = wid & 3, fr = lane & 15, fq = lane >> 4;
    const int K = g.K, nt = K / BK;
    unsigned voffA[2], voffB[2]; int stR[2], stC[2];
#pragma unroll
    for (int i = 0; i < 2; ++i) { int R, C; stage_rc(tid * 16 + i * 8192, R, C); const int Rb = Epi::PERM ? ((R & ~31) + perm32(R & 31)) : R; stR[i] = R; stC[i] = C;
        voffA[i] = (unsigned)(R * K + C) * 2u; voffB[i] = (unsigned)(Rb * K + C) * 2u; }
    const size_t kstep = (size_t)(BK * 2);
    const size_t hstep = (size_t)HALF * K * 2;
    const size_t tstep = 2 * hstep;
    const unsigned ldsw = (unsigned)wid * 1024u;
    const int aoff = lds_byte(wr * 64 + fr, fq * 8), boff = lds_byte(wc * 32 + fr, fq * 8);
#define PG8_SA(b, h) (((b) * 2 + (h)) * HTB)
#define PG8_SB(b, h) ((4 + (b) * 2 + (h)) * HTB)
#define PG8_STAGE(bufoff, gbase, voff) do { _Pragma("unroll") for (int _i = 0; _i < 2; ++_i) \
        __builtin_amdgcn_global_load_lds((const unsigned*)((const char*)(gbase) + (voff)[_i]), (PG8_LAS unsigned*)(lds + (bufoff) + ldsw + _i * 8192), 16, 0, 0); } while (0)
#define PG8_STAGE_A(bufoff, ub, uo, h, ko) do { if constexpr (GATHER) { PG8_STAGE(bufoff, (const char*)g.A + (ko), (uo)[h]); } else { PG8_STAGE(bufoff, (ub) + (size_t)(h) * hstep + (ko), voffA); } } while (0)
#define PG8_LDA(dst, b, h) do { _Pragma("unroll") for (int m = 0; m < 4; ++m) _Pragma("unroll") for (int k = 0; k < 2; ++k) dst[m][k] = *(const PG8_LAS bf16x8*)(lds + PG8_SA(b, h) + aoff + m * 2048 + k * 1024); } while (0)
#define PG8_LDB(dst, b, h) do { _Pragma("unroll") for (int n = 0; n < 2; ++n) _Pragma("unroll") for (int k = 0; k < 2; ++k) dst[n][k] = *(const PG8_LAS bf16x8*)(lds + PG8_SB(b, h) + boff + n * 2048 + k * 1024); } while (0)
#define PG8_MMA(ai, bj, At, Bt) do { __builtin_amdgcn_s_setprio(1); _Pragma("unroll") for (int m = 0; m < 4; ++m) _Pragma("unroll") for (int n = 0; n < 2; ++n) _Pragma("unroll") for (int k = 0; k < 2; ++k) \
        acc[ai][bj][m][n] = __builtin_amdgcn_mfma_f32_16x16x32_bf16(Bt[n][k], At[m][k], acc[ai][bj][m][n], 0, 0, 0); __builtin_amdgcn_s_setprio(0); } while (0)
#define PG8_WAIT_V(n) asm volatile("s_waitcnt vmcnt(" #n ")" ::: "memory")
#define PG8_WAIT_L(n) asm volatile("s_waitcnt lgkmcnt(" #n ")" ::: "memory")
#define PG8_BAR __builtin_amdgcn_s_barrier()
#define PG8_SCHED __builtin_amdgcn_sched_barrier(0)
#define PG8_GOFF(dst, uix) do { if constexpr (GATHER) { _Pragma("unroll") for (int _h = 0; _h < 2; ++_h) _Pragma("unroll") for (int _i = 0; _i < 2; ++_i) \
        dst[_h][_i] = (unsigned)(gtab[(uix) * 256 + _h * HALF + stR[_i]] * K + stC[_i]) * 2u; } } while (0)
    Unit cur, nxt; int ui = 0;
    if (!S.next(0, cur)) return;
    f32x4 acc[2][2][4][2];
#pragma unroll
    for (int a = 0; a < 2; ++a)
#pragma unroll
        for (int b = 0; b < 2; ++b)
#pragma unroll
            for (int m = 0; m < 4; ++m)
#pragma unroll
                for (int n = 0; n < 2; ++n) acc[a][b][m][n] = (f32x4){0.f, 0.f, 0.f, 0.f};
    bf16x8 At[4][2], B0[2][2], B1[2][2];
    unsigned co[2][2] = {{0u, 0u}, {0u, 0u}}, no[2][2] = {{0u, 0u}, {0u, 0u}};
    PG8_GOFF(co, 0);
    typename Epi::State st;
    const char* cA = (const char*)g.A + (size_t)cur.pm * tstep; const char* cB = (const char*)g.Bt + (size_t)S.btile(cur) * tstep;
    S.a_ready(cur);
    PG8_STAGE(PG8_SB(0, 0), cB, voffB); PG8_STAGE(PG8_SB(0, 1), cB + hstep, voffB); PG8_STAGE_A(PG8_SA(0, 0), cA, co, 0, 0); PG8_STAGE_A(PG8_SA(0, 1), cA, co, 1, 0);
    if (wr == 1) PG8_BAR;
    PG8_WAIT_V(2); PG8_BAR;
    PG8_STAGE(PG8_SB(1, 0), cB + kstep, voffB); PG8_STAGE_A(PG8_SA(1, 0), cA, co, 0, kstep); PG8_STAGE(PG8_SB(1, 1), cB + hstep + kstep, voffB);
    PG8_WAIT_V(6); PG8_BAR;
    for (;;) {
        const bool has_next = S.next(ui + 1, nxt);
        const char* nA = has_next ? (const char*)g.A + (size_t)nxt.pm * tstep : cA; const char* nB = has_next ? (const char*)g.Bt + (size_t)S.btile(nxt) * tstep : cB;
        if constexpr (GATHER) { if (has_next) PG8_GOFF(no, ui + 1); else {
#pragma unroll
            for (int h = 0; h < 2; ++h)
#pragma unroll
                for (int i = 0; i < 2; ++i) no[h][i] = co[h][i]; } }
        E.pre(st, cur, wr, wc, fr, fq);
#pragma nounroll
        for (int t = 0; t < nt; t += 2) {
            const bool last = (t == nt - 2);
            const size_t k1 = (size_t)(t + 1) * kstep, k2 = last ? 0 : (size_t)(t + 2) * kstep, k3 = k2 + kstep;
            const char* a2 = last ? nA : cA; const char* b2 = (last ? nB : cB) + k2; const char* b3 = b2 + kstep;
            unsigned so[2][2];
#pragma unroll
            for (int h = 0; h < 2; ++h)
#pragma unroll
                for (int i = 0; i < 2; ++i) so[h][i] = last ? no[h][i] : co[h][i];
            if (last && has_next) S.a_ready(nxt);
            if constexpr (Epi::HAS_MID) { if (t == Epi::MID_T) E.mid(st, acc, cur, wr, wc, fr, fq); }
            PG8_LDB(B0, 0, 0); PG8_LDB(B1, 0, 1); PG8_SCHED; PG8_LDA(At, 0, 0); PG8_STAGE_A(PG8_SA(1, 1), cA, co, 1, k1);
            PG8_WAIT_V(8); PG8_WAIT_L(0); PG8_BAR; PG8_MMA(0, 0, At, B0); PG8_MMA(0, 1, At, B1); PG8_BAR; PG8_SCHED;
            PG8_LDA(At, 0, 1); PG8_STAGE(PG8_SB(0, 0), b2, voffB); PG8_STAGE(PG8_SB(0, 1), b2 + hstep, voffB); PG8_STAGE_A(PG8_SA(0, 0), a2, so, 0, k2);
            PG8_WAIT_V(8); PG8_WAIT_L(0); PG8_BAR; PG8_MMA(1, 0, At, B0); PG8_MMA(1, 1, At, B1); PG8_BAR; PG8_SCHED;
            PG8_LDB(B0, 1, 0); PG8_LDB(B1, 1, 1); PG8_SCHED; PG8_LDA(At, 1, 0); PG8_STAGE_A(PG8_SA(0, 1), a2, so, 1, k2);
            PG8_WAIT_V(8); PG8_WAIT_L(0); PG8_BAR; PG8_MMA(0, 0, At, B0); PG8_MMA(0, 1, At, B1); PG8_BAR; PG8_SCHED;
            PG8_LDA(At, 1, 1); PG8_STAGE(PG8_SB(1, 0), b3, voffB); PG8_STAGE(PG8_SB(1, 1), b3 + hstep, voffB); PG8_STAGE_A(PG8_SA(1, 0), a2, so, 0, k3);
            PG8_WAIT_V(8); PG8_WAIT_L(0); PG8_BAR; PG8_MMA(1, 0, At, B0); PG8_MMA(1, 1, At, B1); PG8_BAR; PG8_SCHED;
        }
        if constexpr (ALIGN_EPI) { if (wr == 0) PG8_BAR; }
        if constexpr (!Epi::AFTER_DRAIN) { E(st, acc, cur, wr, wc, fr, fq); S.done(cur); }
        if (!has_next) break;
#pragma unroll
        for (int a = 0; a < 2; ++a)
#pragma unroll
            for (int b = 0; b < 2; ++b)
#pragma unroll
                for (int m = 0; m < 4; ++m)
#pragma unroll
                    for (int n = 0; n < 2; ++n) acc[a][b][m][n] = (f32x4){0.f, 0.f, 0.f, 0.f};
        cur = nxt; cA = nA; cB = nB; ++ui;
#pragma unroll
        for (int h = 0; h < 2; ++h)
#pragma unroll
            for (int i = 0; i < 2; ++i) co[h][i] = no[h][i];
        if constexpr (ALIGN_EPI) { if (wr == 1) PG8_BAR; }
    }
    PG8_WAIT_V(0);
    if constexpr (!ALIGN_EPI) { if (wr == 0) PG8_BAR; }
    PG8_BAR;
    if constexpr (Epi::AFTER_DRAIN) { E.fused(st, acc, cur, wr, wc, fr, fq, lds, wid, lane); S.done(cur); }
#undef PG8_SA
#undef PG8_SB
#undef PG8_STAGE
#undef PG8_STAGE_A
#undef PG8_LDA
#undef PG8_LDB
#undef PG8_MMA
#undef PG8_WAIT_V
#undef PG8_WAIT_L
#undef PG8_BAR
#undef PG8_SCHED
#undef PG8_GOFF
}
}

#define LAS __attribute__((address_space(3)))
#define GAS __attribute__((address_space(1)))
#define XB_TMO      128
#define XB_XCNT(j)  (256  + 64 * (j))
#define XB_XSUB(j)  (1280 + 64 * (j))
#define XB_XGEN(j)  (2304 + 64 * (j))
#define XB_TOP      3328
#define XB_TOPGEN   3392
#define XCD_BAR_WORDS 3456
#define XB_SPIN_CAP (1u << 18)

__device__ __forceinline__ unsigned xb_ld(unsigned* p)              { return __hip_atomic_load(p, __ATOMIC_RELAXED, __HIP_MEMORY_SCOPE_AGENT); }
__device__ __forceinline__ unsigned xb_add(unsigned* p, unsigned v) { return __hip_atomic_fetch_add(p, v, __ATOMIC_RELAXED, __HIP_MEMORY_SCOPE_AGENT); }
__device__ __forceinline__ unsigned xb_xcc_id() { return (unsigned)__builtin_amdgcn_s_getreg((3 << 11) | 20) & 0xFu; }
#define XB_SPIN(cond, bar) do { unsigned _sp = 0; while (cond) { __builtin_amdgcn_s_sleep(1); \
    if ((++_sp & 255u) == 0u) { if (xb_ld(&(bar)[XB_TMO])) break; if (_sp > XB_SPIN_CAP) { atomicAdd(&(bar)[XB_TMO], 1u); break; } } } } while (0)

struct XcdBarrier {
    unsigned* bar; unsigned x;
    volatile LAS unsigned* st;
};

__device__ __forceinline__ XcdBarrier xcd_barrier_post(unsigned* bar, volatile LAS unsigned* st) {
    XcdBarrier b; b.bar = bar; b.x = xb_xcc_id(); b.st = st;
    if (threadIdx.x == 0) (void)xb_add(&bar[XB_XCNT(b.x)], 1u);
    return b;
}
__device__ __forceinline__ void xcd_barrier_complete(unsigned* bar, unsigned x, unsigned& nloc, unsigned& nx) {
    const unsigned G = gridDim.x * gridDim.y * gridDim.z;
    unsigned sum, cnt, mine, sp = 0u;
    for (;;) {
        sum = 0u; cnt = 0u; mine = 0u;
#pragma unroll
        for (unsigned j = 0; j < 16; ++j) { const unsigned c = xb_ld(&bar[XB_XCNT(j)]); sum += c; cnt += (c > 0u) ? 1u : 0u; mine = (j == x) ? c : mine; }
        if (sum == G) break;
        __builtin_amdgcn_s_sleep(1);
        if ((++sp & 255u) == 0u) { if (xb_ld(&bar[XB_TMO])) break; if (sp > XB_SPIN_CAP) { atomicAdd(&bar[XB_TMO], 1u); break; } }
    }
    nloc = mine > 0u ? mine : 1u; nx = cnt > 0u ? cnt : 1u;
}

__device__ __forceinline__ void xcd_barrier(const XcdBarrier& b) {
    asm volatile("s_waitcnt vmcnt(0)" ::: "memory");
    __syncthreads();
    if (threadIdx.x == 0) {
        unsigned* bar = b.bar;
        __builtin_amdgcn_s_waitcnt(0);
        unsigned nloc = b.st[0], nx = b.st[1];
        if (nloc == 0u) { xcd_barrier_complete(bar, b.x, nloc, nx); b.st[0] = nloc; b.st[1] = nx; }
        const unsigned old = xb_add(&bar[XB_XSUB(b.x)], 1u);
        const unsigned gen = old / nloc;
        if (old + 1u == (gen + 1u) * nloc) {
            __builtin_amdgcn_fence(__ATOMIC_RELEASE, "agent");
            asm volatile("s_waitcnt vmcnt(0)" ::: "memory");
            const unsigned og = xb_add(&bar[XB_TOP], 1u);
            const unsigned tg = og / nx;
            if (og + 1u == (tg + 1u) * nx) xb_add(&bar[XB_TOPGEN], 1u);
            else XB_SPIN(xb_ld(&bar[XB_TOPGEN]) == tg, bar);
            __builtin_amdgcn_fence(__ATOMIC_ACQUIRE, "agent");
            xb_add(&bar[XB_XGEN(b.x)], 1u);
            asm volatile("s_waitcnt vmcnt(0)" ::: "memory");
        } else {
            XB_SPIN(xb_ld(&bar[XB_XGEN(b.x)]) == gen, bar);
            __builtin_amdgcn_fence(__ATOMIC_ACQUIRE, "agent");
            asm volatile("s_waitcnt vmcnt(0)" ::: "memory");
        }
    }
    __syncthreads();
}

typedef unsigned short bf16;
typedef unsigned v4u __attribute__((ext_vector_type(4)));
typedef unsigned v2u __attribute__((ext_vector_type(2)));
typedef float f32x4 __attribute__((ext_vector_type(4)));
typedef float f32x2_t __attribute__((ext_vector_type(2)));
typedef __bf16 bf16x2_t __attribute__((ext_vector_type(2)));
typedef short bf16x8 __attribute__((ext_vector_type(8)));
typedef short s16x4 __attribute__((ext_vector_type(4)));
typedef float f32x16 __attribute__((ext_vector_type(16)));
#define LDS_WAIT() asm volatile("s_waitcnt lgkmcnt(0)" ::: "memory")
#define VM_WAIT() asm volatile("s_waitcnt vmcnt(0)" ::: "memory")
#define SBAR() __builtin_amdgcn_sched_barrier(0)
__device__ __forceinline__ unsigned pk2(float lo, float hi) { f32x2_t v = {lo, hi}; bf16x2_t b = __builtin_convertvector(v, bf16x2_t); return __builtin_bit_cast(unsigned, b); }
__device__ __forceinline__ float bf2f(unsigned short h) { return __builtin_bit_cast(float, (unsigned)h << 16); }
__device__ __forceinline__ float wave_sum(float v) {
#pragma unroll
    for (int o = 1; o < 64; o <<= 1) v += __shfl_xor(v, o);
    return v;
}
__device__ const float INV_FREQ[16] = {1.000000000e+00f, 5.623413324e-01f, 3.162277639e-01f, 1.778279394e-01f, 1.000000015e-01f, 5.623412877e-02f, 3.162277862e-02f, 1.778279431e-02f,
                                       9.999999776e-03f, 5.623413250e-03f, 3.162277862e-03f, 1.778279431e-03f, 1.000000047e-03f, 5.623413017e-04f, 3.162277862e-04f, 1.778279402e-04f};

static_assert((CW_BAR + XCD_BAR_WORDS) * 4 <= (int)CTL_ZERO_BYTES, "CTL words inside the memset region");
namespace att {
#define KSWZ(row, colB) ((row) * 256 + ((colB) ^ (((row) & 7) << 4)))
__device__ __forceinline__ int crow(int r, int hi) { return (r & 3) + 8 * (r >> 2) + 4 * hi; }
__device__ __forceinline__ unsigned cvtpk(float lo, float hi) { return pk2(lo, hi); }
__device__ __forceinline__ int v_st(int k, int c) { const int kk = (k & ~0xC) | ((k & 4) << 1) | ((k & 8) >> 1); return ((kk >> 3) * 2 + (c >> 5)) * 512 + ((kk & 7) * 32 + (c & 31)) * 2; }
__device__ __forceinline__ int v_rd_base(int lane) { return ((lane & 3) << 3) | (((lane >> 2) & 3) << 6) | (((lane >> 4) & 1) << 5) | (((lane >> 5) & 1) << 8); }
constexpr int v_rd_off(int d0, int ks, int half) { return d0 * 512 + ks * 2048 + half * 1024; }
template <int OFF> __device__ __forceinline__ s16x4 tr_read(int vb) {
  s16x4 r; asm volatile("ds_read_b64_tr_b16 %0, %1 offset:%2" : "=&v"(r) : "v"(vb), "i"(OFF) : "memory"); return r;
}
template <int D0> __device__ __forceinline__ void pv_one(f32x16& od, int vb, bf16x8 pa0, bf16x8 pa1, bf16x8 pa2, bf16x8 pa3) {
  const s16x4 l0 = tr_read<v_rd_off(D0, 0, 0)>(vb), h0 = tr_read<v_rd_off(D0, 0, 1)>(vb), l1 = tr_read<v_rd_off(D0, 1, 0)>(vb), h1 = tr_read<v_rd_off(D0, 1, 1)>(vb);
  const s16x4 l2 = tr_read<v_rd_off(D0, 2, 0)>(vb), h2 = tr_read<v_rd_off(D0, 2, 1)>(vb), l3 = tr_read<v_rd_off(D0, 3, 0)>(vb), h3 = tr_read<v_rd_off(D0, 3, 1)>(vb);
  asm volatile("s_waitcnt lgkmcnt(0)" ::: "memory"); SBAR();
#define PK(L, H) (bf16x8){L[0], L[1], L[2], L[3], H[0], H[1], H[2], H[3]}
  od = __builtin_amdgcn_mfma_f32_32x32x16_bf16(pa0, PK(l0, h0), od, 0, 0, 0);
  od = __builtin_amdgcn_mfma_f32_32x32x16_bf16(pa1, PK(l1, h1), od, 0, 0, 0);
  od = __builtin_amdgcn_mfma_f32_32x32x16_bf16(pa2, PK(l2, h2), od, 0, 0, 0);
  od = __builtin_amdgcn_mfma_f32_32x32x16_bf16(pa3, PK(l3, h3), od, 0, 0, 0);
#undef PK
}
__device__ __forceinline__ void pv_2(f32x16* o, int vb, bf16x8 pa0, bf16x8 pa1, bf16x8 pa2, bf16x8 pa3) {
  pv_one<0>(o[0], vb, pa0, pa1, pa2, pa3); pv_one<1>(o[1], vb, pa0, pa1, pa2, pa3);
}
__device__ __forceinline__ void pack_p(const f32x16& p0, const f32x16& p1, bf16x8& pa0, bf16x8& pa1, bf16x8& pa2, bf16x8& pa3) {
#define PK4(P, BASE, OUT) do { unsigned a0 = cvtpk(P[BASE + 0], P[BASE + 1]), a1 = cvtpk(P[BASE + 2], P[BASE + 3]);   \
    unsigned b0 = cvtpk(P[BASE + 4], P[BASE + 5]), b1 = cvtpk(P[BASE + 6], P[BASE + 7]);                              \
    auto r0 = __builtin_amdgcn_permlane32_swap(a0, b0, false, false); auto r1 = __builtin_amdgcn_permlane32_swap(a1, b1, false, false); \
    v4u w = {r0[0], r1[0], r0[1], r1[1]}; OUT = __builtin_bit_cast(bf16x8, w); } while (0)
  PK4(p0, 0, pa0); PK4(p0, 8, pa1); PK4(p1, 0, pa2); PK4(p1, 8, pa3);
#undef PK4
}

namespace mla {
constexpr int NW = 8, QBLK = 32, KVBLK = 64;
constexpr float SCALE = 0.10206207261596575f;
constexpr float THR = 8.f;
constexpr int SHM_V = 8192, SHM_K = 16384, SHM_TOTAL = 2 * SHM_V + 2 * SHM_K + NW * 64 * 4;
__device__ __forceinline__ void partialSM(f32x16& p0, f32x16& p1, float& m_reg, float& mn, float& alpha) {
  constexpr float C = SCALE * LOG2E;
  float pmax = p0[0];
#pragma unroll
  for (int r = 1; r < 16; ++r) pmax = fmaxf(pmax, p0[r]);
#pragma unroll
  for (int r = 0; r < 16; ++r) pmax = fmaxf(pmax, p1[r]);
  { auto rr = __builtin_amdgcn_permlane32_swap(__float_as_uint(pmax), __float_as_uint(pmax), false, false);
    pmax = fmaxf(__uint_as_float(rr[0]), __uint_as_float(rr[1])); }
  if (__builtin_expect(__all(pmax - m_reg <= THR / SCALE), 1)) { mn = m_reg; alpha = 1.f; }
  else { mn = fmaxf(m_reg, pmax); alpha = __builtin_amdgcn_exp2f((m_reg - mn) * C); m_reg = mn; }
  const float mnC = -mn * C;
#pragma unroll
  for (int r = 0; r < 16; ++r) p0[r] = fmaf(p0[r], C, mnC);
#pragma unroll
  for (int r = 0; r < 16; ++r) p1[r] = fmaf(p1[r], C, mnC);
#pragma unroll
  for (int r = 0; r < 16; ++r) p0[r] = __builtin_amdgcn_exp2f(p0[r]);
}
__device__ __forceinline__ void finishSM(f32x16& p0, f32x16& p1, float alpha, float& l_reg, bf16x8& pa0, bf16x8& pa1, bf16x8& pa2, bf16x8& pa3) {
#pragma unroll
  for (int r = 0; r < 16; ++r) p1[r] = __builtin_amdgcn_exp2f(p1[r]);
  float ps = 0;
#pragma unroll
  for (int r = 0; r < 16; ++r) ps += p0[r];
#pragma unroll
  for (int r = 0; r < 16; ++r) ps += p1[r];
  { auto rr = __builtin_amdgcn_permlane32_swap(__float_as_uint(ps), __float_as_uint(ps), false, false);
    ps = __uint_as_float(rr[0]) + __uint_as_float(rr[1]); }
  l_reg = l_reg * alpha + ps;
  pack_p(p0, p1, pa0, pa1, pa2, pa3);
}
__device__ __forceinline__ void qkt(f32x16& p0, f32x16& p1, const char* Ks, const bf16x8* qr, int r32, int hi) {
  p0 = f32x16{}; p1 = f32x16{};
#pragma unroll
  for (int d0 = 0; d0 < 6; ++d0) { const int cb = (d0 * 16 + hi * 8) * 2;
    const bf16x8 b0 = *reinterpret_cast<const bf16x8*>(Ks + KSWZ(r32, cb));
    const bf16x8 b1 = *reinterpret_cast<const bf16x8*>(Ks + KSWZ(32 + r32, cb));
    p0 = __builtin_amdgcn_mfma_f32_32x32x16_bf16(b0, qr[d0], p0, 0, 0, 0);
    p1 = __builtin_amdgcn_mfma_f32_32x32x16_bf16(b1, qr[d0], p1, 0, 0, 0); }
}
__device__ __forceinline__ void unit(int b, int h, int qb, const bf16* __restrict__ QB, const bf16* __restrict__ KVB, const bf16* __restrict__ KR,
                                     const float* __restrict__ COS, const float* __restrict__ SIN, bf16* __restrict__ Y, char* lds) {
  int tid_ = threadIdx.x; asm volatile("" : "+v"(tid_));
  const int tid = tid_, wid = tid >> 6, lane = tid & 63, r32 = lane & 31, hi = lane >> 5;
  char* V_lds = lds; char* K_lds = lds + 2 * SHM_V;
  float* ws = (float*)(lds + 2 * SHM_V + 2 * SHM_K) + wid * 64; float* li_l = ws; float* al_l = ws + 32;
  float m_reg = -1e30f, l_reg = 0; f32x16 o[2] = {}; bf16x8 qr[6];
  const size_t tokq = (size_t)b * SEQ + qb * 256 + wid * QBLK + r32;
  { const bf16* Qw = QB + tokq * 768 + h * 96 + hi * 8;
#pragma unroll
    for (int d0 = 0; d0 < 6; ++d0) qr[d0] = *reinterpret_cast<const bf16x8*>(Qw + d0 * 16);
    const f32x4 c0 = *(const f32x4*)(COS + tokq * 16 + hi * 8), c1 = *(const f32x4*)(COS + tokq * 16 + hi * 8 + 4);
    const f32x4 s0 = *(const f32x4*)(SIN + tokq * 16 + hi * 8), s1 = *(const f32x4*)(SIN + tokq * 16 + hi * 8 + 4);
    float o1[8], o2[8];
#pragma unroll
    for (int j = 0; j < 8; ++j) { const float t1 = bf2f((unsigned short)qr[4][j]), t2 = bf2f((unsigned short)qr[5][j]); const float c = j < 4 ? c0[j & 3] : c1[j & 3], s = j < 4 ? s0[j & 3] : s1[j & 3];
      o1[j] = t1 * c - t2 * s; o2[j] = t1 * s + t2 * c; }
    v4u w1 = {pk2(o1[0], o1[1]), pk2(o1[2], o1[3]), pk2(o1[4], o1[5]), pk2(o1[6], o1[7])}, w2 = {pk2(o2[0], o2[1]), pk2(o2[2], o2[3]), pk2(o2[4], o2[5]), pk2(o2[6], o2[7])};
    qr[4] = __builtin_bit_cast(bf16x8, w1); qr[5] = __builtin_bit_cast(bf16x8, w2); }
  const int ksr = tid >> 4, kcc = tid & 15, kc = kcc < 12 ? kcc : kcc - 4;
  const bf16* kbase = kc < 8 ? KVB + ((size_t)b * SEQ + ksr) * 1024 + h * 128 + kc * 8 : KR + ((size_t)b * SEQ + ksr) * 32 + (kc - 8) * 8;
  const int kstr = kc < 8 ? 1024 : 32;
  const int vrow = tid >> 3, vcc = tid & 7;
  const bf16* vbase = KVB + ((size_t)b * SEQ + vrow) * 1024 + h * 128 + 64 + vcc * 8;
  const int kst0 = KSWZ(ksr, kc * 16), kst1 = KSWZ(32 + ksr, kc * 16), vst = v_st(vrow, vcc * 8);
  const int vb0 = (int)(uintptr_t)V_lds + v_rd_base(lane);
  struct { bf16x8 vs, ks0, ks1; } sr_[2];
#define SLOAD(i, k0) do { sr_[i].vs = *reinterpret_cast<const bf16x8*>(vbase + (size_t)(k0) * 1024); \
    sr_[i].ks0 = *reinterpret_cast<const bf16x8*>(kbase + (size_t)(k0) * kstr); sr_[i].ks1 = *reinterpret_cast<const bf16x8*>(kbase + (size_t)((k0) + 32) * kstr); } while (0)
#define SWRITE(bb, i) do { *(bf16x8*)(V_lds + (bb) * SHM_V + vst) = sr_[i].vs; *(bf16x8*)(K_lds + (bb) * SHM_K + kst0) = sr_[i].ks0; *(bf16x8*)(K_lds + (bb) * SHM_K + kst1) = sr_[i].ks1; } while (0)
#define SWAIT() asm volatile("s_waitcnt vmcnt(3)" ::: "memory")
#define RESC(a) do { if (__any((a) < 1.f)) { if (hi == 0) al_l[r32] = (a); asm volatile("s_waitcnt lgkmcnt(0)" ::: "memory"); \
    _Pragma("unroll") for (int d = 0; d < 2; ++d) _Pragma("unroll") for (int r = 0; r < 16; ++r) o[d][r] *= al_l[crow(r, hi)]; } } while (0)
  f32x16 pA0, pA1, pB0, pB1; float mnA, mnB, alA, alB; bf16x8 pa0, pa1, pa2, pa3; constexpr int NT = SEQ / KVBLK;
  constexpr int SE = 0, SO = 1;
  SLOAD(SE, 0); asm volatile("s_waitcnt vmcnt(0)" ::: "memory"); SWRITE(0, SE); __syncthreads();
  qkt(pA0, pA1, K_lds, qr, r32, hi); partialSM(pA0, pA1, m_reg, mnA, alA);
  SLOAD(SO, KVBLK); SLOAD(SE, 2 * KVBLK);
  SWAIT(); SWRITE(1, SO); __syncthreads();
  for (int j = 1; j + 1 < NT; j += 2) {
    SBAR(); qkt(pB0, pB1, K_lds + SHM_K, qr, r32, hi);
    finishSM(pA0, pA1, alA, l_reg, pa0, pa1, pa2, pa3); SBAR();
    SLOAD(SO, (j + 2) * KVBLK); SBAR();
    pv_2(o, vb0, pa0, pa1, pa2, pa3); partialSM(pB0, pB1, m_reg, mnB, alB);
    __syncthreads(); SWAIT(); SWRITE(0, SE);
    RESC(alB); __syncthreads();
    SBAR(); qkt(pA0, pA1, K_lds, qr, r32, hi);
    finishSM(pB0, pB1, alB, l_reg, pa0, pa1, pa2, pa3); SBAR();
    if (j + 3 < NT) SLOAD(SE, (j + 3) * KVBLK); SBAR();
    pv_2(o, vb0 + SHM_V, pa0, pa1, pa2, pa3); partialSM(pA0, pA1, m_reg, mnA, alA);
    __syncthreads(); SWAIT(); SWRITE(1, SO);
    RESC(alA); __syncthreads();
  }
  SBAR(); qkt(pB0, pB1, K_lds + SHM_K, qr, r32, hi);
  finishSM(pA0, pA1, alA, l_reg, pa0, pa1, pa2, pa3); SBAR();
  pv_2(o, vb0, pa0, pa1, pa2, pa3); partialSM(pB0, pB1, m_reg, mnB, alB);
  __syncthreads(); RESC(alB);
  finishSM(pB0, pB1, alB, l_reg, pa0, pa1, pa2, pa3); SBAR();
  pv_2(o, vb0 + SHM_V, pa0, pa1, pa2, pa3);
  if (hi == 0) li_l[r32] = l_reg; asm volatile("s_waitcnt lgkmcnt(0)" ::: "memory");
  float rli[16];
#pragma unroll
  for (int r = 0; r < 16; ++r) rli[r] = __builtin_amdgcn_rcpf(li_l[crow(r, hi)]);
  bf16* Ow = Y + ((size_t)b * SEQ + qb * 256 + wid * QBLK) * 1024 + 512 + h * 64;
#pragma unroll
  for (int r = 0; r < 16; ++r) { const int orow = crow(r, hi);
#pragma unroll
    for (int d0 = 0; d0 < 2; ++d0) Ow[(size_t)orow * 1024 + d0 * 32 + r32] = (bf16)(pk2(o[d0][r] * rli[r], 0.f) & 0xffffu); }
  __syncthreads();
#undef SLOAD
#undef SWRITE
#undef SWAIT
#undef RESC
}
}

namespace wnd {
constexpr int LDS_V = 0, LDS_K = 8192, LDS_TAB = 8192 + 16384, LDS_WS = LDS_TAB + 2048, LDS_TOTAL = LDS_WS + 8 * 256;
__device__ __forceinline__ int t5_bucket(int rel) {
  const int n = rel < 0 ? -rel : rel; int bk;
  if (n < 8) bk = n; else bk = 8 + (n > 11) + (n > 15) + (n > 22) + (n > 31) + (n > 45) + (n > 63) + (n > 90);
  return (rel > 0 ? 16 : 0) + bk;
}
__device__ __forceinline__ void unit(int b, int h, int qb, const bf16* __restrict__ QA, const bf16* __restrict__ KVA, const float* __restrict__ rel_bias, const float* __restrict__ sink,
                                     bf16* __restrict__ Y, char* lds) {
  int tid_ = threadIdx.x; asm volatile("" : "+v"(tid_));
  const int tid = tid_, wid = tid >> 6, lane = tid & 63, r32 = lane & 31, hi = lane >> 5, kvh = h >> 2;
  char* V_lds = lds + LDS_V; char* K_lds = lds + LDS_K; float* tab = (float*)(lds + LDS_TAB); float* al_l = (float*)(lds + LDS_WS) + wid * 64; float* li_l = al_l + 32;
  for (int i = tid; i < 385; i += 512) { const int rel = i - 192, n = rel < 0 ? -rel : rel; tab[i] = n <= 128 ? rel_bias[t5_bucket(rel) * 8 + h] * LOG2E : -1e30f; }
  const int q0 = qb * 256;
  bf16x8 qr[4];
  { const bf16* Qw = QA + ((size_t)b * SEQ + q0 + wid * 32 + r32) * 512 + h * 64 + hi * 8;
#pragma unroll
    for (int d0 = 0; d0 < 4; ++d0) qr[d0] = *reinterpret_cast<const bf16x8*>(Qw + d0 * 16); }
  float m_reg = sink[h] * LOG2E, l_reg = 1.0f; f32x16 o[2] = {};
  const int srow = tid >> 3, scc = tid & 7;
  const bf16* kbase = KVA + (size_t)b * SEQ * 256 + kvh * 64 + scc * 8; const bf16* vbase = kbase + 128;
  const int kst = KSWZ(srow, scc * 16), vst = v_st(srow, scc * 8);
  const int vb0 = (int)(uintptr_t)V_lds + v_rd_base(lane);
  constexpr float C = 0.125f * LOG2E;
  const int t_lo = qb == 0 ? 2 : 0, t_hi = qb == SEQ / 256 - 1 ? 6 : 8, wlo = wid >> 1;
  for (int t = t_lo; t < t_hi; ++t) {
    const int k0 = q0 - 128 + 64 * t;
    const bf16x8 kreg = *reinterpret_cast<const bf16x8*>(kbase + (size_t)(k0 + srow) * 256), vreg = *reinterpret_cast<const bf16x8*>(vbase + (size_t)(k0 + srow) * 256);
    __syncthreads();
    *(bf16x8*)(K_lds + kst) = kreg; *(bf16x8*)(V_lds + vst) = vreg;
    __syncthreads();
    if (t >= wlo && t <= wlo + 4) {
      f32x16 p0 = {}, p1 = {};
#pragma unroll
      for (int d0 = 0; d0 < 4; ++d0) { const int cb = (d0 * 16 + hi * 8) * 2;
        const bf16x8 b0 = *reinterpret_cast<const bf16x8*>(K_lds + KSWZ(r32, cb)), b1 = *reinterpret_cast<const bf16x8*>(K_lds + KSWZ(32 + r32, cb));
        p0 = __builtin_amdgcn_mfma_f32_32x32x16_bf16(b0, qr[d0], p0, 0, 0, 0); p1 = __builtin_amdgcn_mfma_f32_32x32x16_bf16(b1, qr[d0], p1, 0, 0, 0); }
      const int base = k0 - (q0 + wid * 32 + r32) + 192 + 4 * hi;
#pragma unroll
      for (int r = 0; r < 16; ++r) { const int i0 = base + (r & 3) + 8 * (r >> 2); p0[r] = fmaf(p0[r], C, tab[i0]); p1[r] = fmaf(p1[r], C, tab[i0 + 32]); }
      float pmax = p0[0];
#pragma unroll
      for (int r = 1; r < 16; ++r) pmax = fmaxf(pmax, p0[r]);
#pragma unroll
      for (int r = 0; r < 16; ++r) pmax = fmaxf(pmax, p1[r]);
      { auto rr = __builtin_amdgcn_permlane32_swap(__float_as_uint(pmax), __float_as_uint(pmax), false, false); pmax = fmaxf(__uint_as_float(rr[0]), __uint_as_float(rr[1])); }
      const float mn = fmaxf(m_reg, pmax), alpha = __builtin_amdgcn_exp2f(m_reg - mn); m_reg = mn;
      float ps = 0.f;
#pragma unroll
      for (int r = 0; r < 16; ++r) { p0[r] = __builtin_amdgcn_exp2f(p0[r] - mn); p1[r] = __builtin_amdgcn_exp2f(p1[r] - mn); ps += p0[r] + p1[r]; }
      { auto rr = __builtin_amdgcn_permlane32_swap(__float_as_uint(ps), __float_as_uint(ps), false, false); ps = __uint_as_float(rr[0]) + __uint_as_float(rr[1]); }
      l_reg = l_reg * alpha + ps;
      if (__any(alpha < 1.f)) { if (hi == 0) al_l[r32] = alpha; asm volatile("s_waitcnt lgkmcnt(0)" ::: "memory");
#pragma unroll
        for (int d = 0; d < 2; ++d)
#pragma unroll
          for (int r = 0; r < 16; ++r) o[d][r] *= al_l[crow(r, hi)]; }
      bf16x8 pa0, pa1, pa2, pa3; pack_p(p0, p1, pa0, pa1, pa2, pa3);
      SBAR(); pv_2(o, vb0, pa0, pa1, pa2, pa3);
    }
  }
  if (hi == 0) li_l[r32] = l_reg; asm volatile("s_waitcnt lgkmcnt(0)" ::: "memory");
  float rli[16];
#pragma unroll
  for (int r = 0; r < 16; ++r) rli[r] = __builtin_amdgcn_rcpf(li_l[crow(r, hi)]);
  bf16* Ow = Y + ((size_t)b * SEQ + q0 + wid * 32) * 1024 + h * 64;
#pragma unroll
  for (int r = 0; r < 16; ++r) { const int orow = crow(r, hi);
#pragma unroll
    for (int d0 = 0; d0 < 2; ++d0) Ow[(size_t)orow * 1024 + d0 * 32 + r32] = (bf16)(pk2(o[d0][r] * rli[r], 0.f) & 0xffffu); }
  __syncthreads();
}
}
#undef KSWZ
}

struct Frame {
    char* lds; int tid, lane, wave, vcu, G, gw, NGW;
    unsigned char* ws;
};

struct TrItem { const float* src; bf16* dst; int N, ldk; };
__device__ __forceinline__ void tr_load(const TrItem& it, f32x4 (&v)[8], int lane) {
#pragma unroll
    for (int q = 0; q < 8; ++q) v[q] = *(const f32x4*)(it.src + (size_t)(8 * q + (lane >> 3)) * it.N + 4 * (lane & 7));
}
__device__ __forceinline__ void tr_store(const TrItem& it, const f32x4 (&v)[8], float* scr, int lane) {
#pragma unroll
    for (int q = 0; q < 8; ++q) { float* s = scr + (8 * q + (lane >> 3)) * 33 + 4 * (lane & 7); s[0] = v[q].x; s[1] = v[q].y; s[2] = v[q].z; s[3] = v[q].w; }
    LDS_WAIT(); asm volatile("" ::: "memory");
    const int c = lane & 7;
#pragma unroll
    for (int j = 0; j < 4; ++j) { const int n = (lane >> 3) + 8 * j; const float* s = scr + (8 * c) * 33 + n;
        v4u o; o.x = pk2(s[0 * 33], s[1 * 33]); o.y = pk2(s[2 * 33], s[3 * 33]); o.z = pk2(s[4 * 33], s[5 * 33]); o.w = pk2(s[6 * 33], s[7 * 33]);
        *(v4u*)(it.dst + (size_t)n * it.ldk + 8 * c) = o; }
    LDS_WAIT(); asm volatile("" ::: "memory");
}
__device__ __forceinline__ void transpose_item(const float* __restrict__ W, int N, int k0, int n0, bf16* dst  , int ldk, float* scr, int lane) {
    TrItem it{W + (size_t)k0 * N + n0, dst + k0, N, ldk}; f32x4 v[8]; tr_load(it, v, lane); tr_store(it, v, scr, lane);
}

__device__ __forceinline__ void p0_prologue(const Frame& F) {
    int tid = threadIdx.x; asm volatile("" : "+v"(tid)); const int lane = tid & 63;
    const KArgs ka = kargs();
    float* scr = (float*)(F.lds + F.wave * 16384);
    unsigned char* ws = F.ws;
    const float* w_in = (const float*)ka->in[5]; const float* w_uq = (const float*)ka->in[9]; const float* w_ukv = (const float*)ka->in[10]; const float* w_pp = (const float*)ka->in[21];
    constexpr int I_IN = 16 * 37, I_UQ = 4 * 24, I_UKV = 2 * 32, I_PP = 4 * 32;
    constexpr int NITEMS = I_IN + I_UQ + I_UKV + I_PP;
    for (int it = F.gw; it < NITEMS; it += F.NGW) {
        int r = it;
        if (r < I_IN) { const int kb = r / 37, nb = r % 37; transpose_item(w_in, IN_COLS, 64 * kb, 32 * nb, (bf16*)(ws + WS_WIN) + (size_t)(32 * nb) * 1024, 1024, scr, lane); continue; } r -= I_IN;
        if (r < I_UQ) { const int kb = r / 24, nb = r % 24; transpose_item(w_uq, 768, 64 * kb, 32 * nb, (bf16*)(ws + WS_WUQ) + (size_t)(32 * nb) * 256, 256, scr, lane); continue; } r -= I_UQ;
        if (r < I_UKV) { const int kb = r / 32, nb = r % 32; transpose_item(w_ukv, 1024, 64 * kb, 32 * nb, (bf16*)(ws + WS_WUKV) + (size_t)(32 * nb) * 256, 256, scr, lane); continue; } r -= I_UKV;
        { const int kb = r / 32, nb = r % 32; transpose_item(w_pp, 1024, 64 * kb, 32 * nb, (bf16*)(ws + WS_WPP) + (size_t)(32 * nb) * 256, 256, scr, lane); }
    }
    const int gt = F.vcu * 512 + tid, NGT = F.G * 512;
    for (int i = gt; i < 96 * 128; i += NGT) ((v4u*)((bf16*)(ws + WS_WIN) + (size_t)IN_COLS * 1024))[i] = (v4u){0u, 0u, 0u, 0u};
    for (int i = gt; i < 1024 * 16; i += NGT) *(v4u*)((bf16*)(ws + WS_WUKV) + (size_t)(i >> 4) * 256 + 128 + (i & 15) * 8) = (v4u){0u, 0u, 0u, 0u};
    const int* positions = (const int*)ka->in[2];
    for (int i = gt; i < T * 16; i += NGT) {
        const float ang = (float)positions[i >> 4] * INV_FREQ[i & 15];
        const double x = (double)ang, q = __builtin_rint(x * 0.63661977236758134308);
        const double r = (x - q * 1.5707963267948966192) - q * 6.123233995736766036e-17, r2 = r * r;
        const double sn = r * (1.0 + r2 * (-1.0 / 6 + r2 * (1.0 / 120 + r2 * (-1.0 / 5040 + r2 * (1.0 / 362880 + r2 * (-1.0 / 39916800 + r2 * (1.0 / 6227020800.0)))))));
        const double cs = 1.0 + r2 * (-0.5 + r2 * (1.0 / 24 + r2 * (-1.0 / 720 + r2 * (1.0 / 40320 + r2 * (-1.0 / 3628800 + r2 * (1.0 / 479001600.0 + r2 * (-1.0 / 87178291200.0)))))));
        const int qi = (int)((long long)q & 3);
        const double c_ = (qi == 0) ? cs : (qi == 1) ? -sn : (qi == 2) ? -cs : sn, s_ = (qi == 0) ? sn : (qi == 1) ? cs : (qi == 2) ? -sn : -cs;
        ((float*)(ws + WS_COS))[i] = (float)c_; ((float*)(ws + WS_SIN))[i] = (float)s_;
    }
    const float* x = (const float*)ka->in[0]; const float* g = (const float*)ka->in[4]; bf16* H = (bf16*)(ws + WS_HB); const float* p = (const float*)ka->in[1]; bf16* PB = (bf16*)(ws + WS_PB);
    for (int m = F.gw; m < T; m += F.NGW) {
        { const f32x4 pv = ((const f32x4*)(p + (size_t)m * PLE))[lane]; ((unsigned long long*)(PB + (size_t)m * PLE))[lane] = (unsigned long long)pk2(pv.x, pv.y) | ((unsigned long long)pk2(pv.z, pv.w) << 32); }
        const f32x4* xr = (const f32x4*)(x + (size_t)m * DM) + lane; f32x4 v[4]; float s = 0.f;
#pragma unroll
        for (int j = 0; j < 4; ++j) { v[j] = xr[64 * j]; s += (v[j].x * v[j].x + v[j].y * v[j].y) + (v[j].z * v[j].z + v[j].w * v[j].w); }
        const float rstd = 1.0f / sqrtf(wave_sum(s) * (1.0f / DM) + EPS);
        unsigned long long* o8 = (unsigned long long*)(H + (size_t)m * DM) + lane;
#pragma unroll
        for (int j = 0; j < 4; ++j) { const f32x4 gg = ((const f32x4*)g)[lane + 64 * j];
            o8[64 * j] = (unsigned long long)pk2(v[j].x * rstd * gg.x, v[j].y * rstd * gg.y) | ((unsigned long long)pk2(v[j].z * rstd * gg.z, v[j].w * rstd * gg.w) << 32); }
    }
}

constexpr int LATE_OUT = 16 * 32, LATE_G = 16 * 16 * 16, LATE_D = 16 * 8 * 32, LATE_PG = 16 * 32, LATE_N = LATE_OUT + 2 * LATE_G + LATE_D + LATE_PG;
__device__ __forceinline__ TrItem late_item(KArgs ka, unsigned char* ws, int r) {
    if (r < LATE_OUT) { const int kb = r / 32, nb = r % 32; return TrItem{(const float*)ka->in[13] + (size_t)(64 * kb) * 1024 + 32 * nb, (bf16*)(ws + WS_WOUT) + (size_t)(32 * nb) * 1024 + 64 * kb, 1024, 1024}; } r -= LATE_OUT;
    if (r < 2 * LATE_G) { const int up = r >= LATE_G; if (up) r -= LATE_G; const int e = r / 256, q = r % 256, kb = q / 16, nb = q % 16, n0 = 32 * nb;
        const size_t drow = (size_t)e * 1024 + 256 * (n0 / 128) + (n0 % 128) + (up ? 128 : 0);
        return TrItem{(const float*)ka->in[up ? 17 : 16] + (size_t)e * 1024 * 512 + (size_t)(64 * kb) * 512 + n0, (bf16*)(ws + WS_WGU) + drow * 1024 + 64 * kb, 512, 1024}; } r -= 2 * LATE_G;
    if (r < LATE_D) { const int e = r / 256, q = r % 256, kb = q / 32, nb = q % 32;
        return TrItem{(const float*)ka->in[18] + (size_t)e * 512 * 1024 + (size_t)(64 * kb) * 1024 + 32 * nb, (bf16*)(ws + WS_WD) + ((size_t)e * 1024 + 32 * nb) * 512 + 64 * kb, 1024, 512}; } r -= LATE_D;
    { const int kb = r / 32, nb = r % 32; return TrItem{(const float*)ka->in[20] + (size_t)(64 * kb) * 1024 + 32 * nb, (bf16*)(ws + WS_WPG) + (size_t)(32 * nb) * 1024 + 64 * kb, 1024, 1024}; }
}
__device__ __forceinline__ void convert_late_weights(const Frame& F, int lo, int hi, int widx, int nw) {
    int lane_ = threadIdx.x & 63; asm volatile("" : "+v"(lane_));
    const KArgs ka = kargs(); unsigned char* ws = F.ws; float* scr = (float*)(F.lds + F.wave * 16384);
    int it = lo + widx; if (it >= hi) return;
    TrItem a = late_item(ka, ws, it), b = a; f32x4 va[8], vb[8]; tr_load(a, va, lane_);
    for (;;) {
        const int i1 = it + nw; const bool h1 = i1 < hi; if (h1) { b = late_item(ka, ws, i1); tr_load(b, vb, lane_); }
        tr_store(a, va, scr, lane_); if (!h1) break;
        const int i2 = i1 + nw; const bool h2 = i2 < hi; if (h2) { a = late_item(ka, ws, i2); tr_load(a, va, lane_); }
        tr_store(b, vb, scr, lane_); if (!h2) break;
        it = i2;
    }
}

__device__ __forceinline__ void p5_group_norm(const Frame& F) {
    int tid = threadIdx.x; asm volatile("" : "+v"(tid)); const int lane = tid & 63;
    const KArgs ka = kargs();
    bf16* Y = (bf16*)(F.ws + WS_Y); const float* ga = (const float*)ka->in[11]; const float* gb = (const float*)ka->in[12];
    for (int m = F.gw; m < T; m += F.NGW) {
        v4u* yr = (v4u*)(Y + (size_t)m * 1024) + lane;
#pragma unroll
        for (int half = 0; half < 2; ++half) { const v4u w = yr[64 * half]; float f[8];
            f[0] = bf2f(w.x & 0xffff); f[1] = bf2f(w.x >> 16); f[2] = bf2f(w.y & 0xffff); f[3] = bf2f(w.y >> 16); f[4] = bf2f(w.z & 0xffff); f[5] = bf2f(w.z >> 16); f[6] = bf2f(w.w & 0xffff); f[7] = bf2f(w.w >> 16);
            float s = 0.f;
#pragma unroll
            for (int j = 0; j < 8; ++j) s += f[j] * f[j];
            const float rstd = 1.0f / sqrtf(wave_sum(s) * (1.0f / 512) + EPS);
            const float* g = (half ? gb : ga) + 8 * lane; const f32x4 g0 = *(const f32x4*)g, g1 = *(const f32x4*)(g + 4);
            v4u o; o.x = pk2(f[0] * rstd * g0.x, f[1] * rstd * g0.y); o.y = pk2(f[2] * rstd * g0.z, f[3] * rstd * g0.w); o.z = pk2(f[4] * rstd * g1.x, f[5] * rstd * g1.y); o.w = pk2(f[6] * rstd * g1.z, f[7] * rstd * g1.w);
            yr[64 * half] = o; }
    }
}

#define BFLY(a, N, BIT) do { const bool up_ = (lane & (BIT)) != 0; _Pragma("unroll") for (int j_ = 0; j_ < (N); ++j_) { const float keep_ = up_ ? a[j_ + (N)] : a[j_], send_ = up_ ? a[j_] : a[j_ + (N)]; a[j_] = keep_ + __shfl_xor(send_, (BIT)); } } while (0)
__device__ __forceinline__ void p7_ffn_norm_router(const Frame& F) {
    int tid = threadIdx.x; asm volatile("" : "+v"(tid)); const int lane = tid & 63;
    const KArgs ka = kargs();
    const float* x1 = ka->out; const float* g = (const float*)ka->in[14]; const float* w_router = (const float*)ka->in[15]; bf16* H = (bf16*)(F.ws + WS_HB); float* AFF = (float*)(F.ws + WS_AFF);
    f32x4* W4 = (f32x4*)F.lds; float* W1 = (float*)F.lds;
    f32x4 v[4][4]; int m0 = F.gw * 4;
#pragma unroll
    for (int r = 0; r < 4; ++r) { const f32x4* xr = (const f32x4*)(x1 + (size_t)(m0 + r) * DM) + lane;
#pragma unroll
        for (int j = 0; j < 4; ++j) v[r][j] = xr[64 * j]; }
    for (int idx = tid; idx < 1024 * 16; idx += 512) { const int k = idx >> 4, e = idx & 15, l = (k & 255) >> 2, j = k >> 8, i = k & 3;
        W1[((e * 4 + i) * 64 + l) * 4 + j] = g[k] * w_router[idx]; }
    __syncthreads();
    f32x4 gg[4];
#pragma unroll
    for (int j = 0; j < 4; ++j) gg[j] = ((const f32x4*)g)[lane + 64 * j];
    for (; m0 < T; m0 += F.NGW * 4) {
        float ss[4];
#pragma unroll
        for (int r = 0; r < 4; ++r) { float s = 0.f;
#pragma unroll
            for (int j = 0; j < 4; ++j) s += (v[r][j].x * v[r][j].x + v[r][j].y * v[r][j].y) + (v[r][j].z * v[r][j].z + v[r][j].w * v[r][j].w);
            ss[r] = s; }
        BFLY(ss, 2, 32); BFLY(ss, 1, 16);
        float sq = ss[0]; sq += __shfl_xor(sq, 8); sq += __shfl_xor(sq, 4); sq += __shfl_xor(sq, 2); sq += __shfl_xor(sq, 1);
        const float rstd = 1.0f / sqrtf(sq * (1.0f / DM) + EPS);
#pragma unroll
        for (int r = 0; r < 4; ++r) { const float rs = __uint_as_float((unsigned)__builtin_amdgcn_readlane((int)__float_as_uint(rstd), 16 * r)); unsigned long long* o8 = (unsigned long long*)(H + (size_t)(m0 + r) * DM) + lane;
#pragma unroll
            for (int j = 0; j < 4; ++j) { const f32x4 h = v[r][j] * rs * gg[j]; o8[64 * j] = (unsigned long long)pk2(h.x, h.y) | ((unsigned long long)pk2(h.z, h.w) << 32); } }
        float a[64];
#pragma unroll
        for (int e = 0; e < 16; ++e) { float acc[4] = {0.f, 0.f, 0.f, 0.f};
#pragma unroll
            for (int i = 0; i < 4; ++i) { const f32x4 w = W4[(e * 4 + i) * 64 + lane];
#pragma unroll
                for (int r = 0; r < 4; ++r) acc[r] += (v[r][0][i] * w[0] + v[r][1][i] * w[1]) + (v[r][2][i] * w[2] + v[r][3][i] * w[3]); }
#pragma unroll
            for (int r = 0; r < 4; ++r) a[r * 16 + e] = acc[r];
            if (e & 1) asm volatile("" ::: "memory"); }
        BFLY(a, 32, 32); BFLY(a, 16, 16);
        const int mn = m0 + F.NGW * 4;
        if (mn < T) {
#pragma unroll
            for (int r = 0; r < 4; ++r) { const f32x4* xr = (const f32x4*)(x1 + (size_t)(mn + r) * DM) + lane;
#pragma unroll
                for (int j = 0; j < 4; ++j) v[r][j] = xr[64 * j]; } }
        BFLY(a, 8, 8); BFLY(a, 4, 4); BFLY(a, 2, 2); BFLY(a, 1, 1);
        const float logit = a[0] * rstd;
        float mx = logit; mx = fmaxf(mx, __shfl_xor(mx, 8)); mx = fmaxf(mx, __shfl_xor(mx, 4)); mx = fmaxf(mx, __shfl_xor(mx, 2)); mx = fmaxf(mx, __shfl_xor(mx, 1));
        const float ex = __expf(logit - mx); float den = ex; den += __shfl_xor(den, 8); den += __shfl_xor(den, 4); den += __shfl_xor(den, 2); den += __shfl_xor(den, 1);
        { const int m = m0 + (lane >> 4); AFF[((size_t)(m >> 11) * 16 + (lane & 15)) * SEQ + (m & (SEQ - 1))] = ex / den; }
    }
    __syncthreads();
}

__device__ __forceinline__ void p8_topk(const Frame& F, int widx, int nwg) {
    int tid = threadIdx.x; asm volatile("" : "+v"(tid)); const int lane = tid & 63, wave = tid >> 6;
    unsigned char* ws = F.ws; const float* AFF = (const float*)(ws + WS_AFF); int* INV = (int*)(ws + WS_INV); int* SEL = (int*)(ws + WS_SEL); float* VAL = (float*)(ws + WS_VAL);
    unsigned long long* keys = (unsigned long long*)F.lds;
    for (int task = widx; task < NBE; task += nwg) {
        const int b = task >> 4, e = task & 15;
        for (int i = tid; i < SEQ; i += 512) keys[i] = ((unsigned long long)__float_as_uint(AFF[(size_t)task * SEQ + i]) << 32) | (unsigned)(SEQ - 1 - i);
        __syncthreads();
        for (int k = 2; k <= SEQ; k <<= 1) {
            int j = k >> 1;
            if (j >= 256) {
                for (; j >= 256; j >>= 1) {
                    for (int p = tid; p < SEQ / 2; p += 512) { const int i = ((p & ~(j - 1)) << 1) | (p & (j - 1)), l = i | j; const bool desc = (i & k) == 0;
                        const unsigned long long x = keys[i], y = keys[l]; if ((x < y) == desc) { keys[i] = y; keys[l] = x; } }
                    __syncthreads();
                }
            }
            for (; j > 0; j >>= 1) {
#pragma unroll
                for (int q = lane; q < 128; q += 64) { const int li = ((q & ~(j - 1)) << 1) | (q & (j - 1)), i = wave * 256 + li, l = i | j; const bool desc = (i & k) == 0;
                    const unsigned long long x = keys[i], y = keys[l]; if ((x < y) == desc) { keys[i] = y; keys[l] = x; } }
                asm volatile("s_waitcnt lgkmcnt(0)" ::: "memory");
            }
            if (k >= 256) __syncthreads();
        }
        __syncthreads();
        for (int c = tid; c < SEQ; c += 512) { const unsigned long long kk = keys[c]; const int idx = SEQ - 1 - (int)(unsigned)(kk & 0xffffffffu);
            if (c < CAP) { SEL[task * CAP + c] = idx; VAL[task * CAP + c] = __uint_as_float((unsigned)(kk >> 32)); INV[((size_t)b * SEQ + idx) * 16 + e] = c; }
            else INV[((size_t)b * SEQ + idx) * 16 + e] = -1; }
        __syncthreads();
    }
}

__device__ __forceinline__ void p11_row(const bf16* OB, int b, int inv, unsigned mask, int lane, f32x4 (&v)[4]) {
    while (mask) {
        v2u w[4][4]; int n = 0;
#pragma unroll
        for (int q = 0; q < 4; ++q) if (mask) { const int e = __builtin_ctz(mask); mask &= mask - 1; const int c = __builtin_amdgcn_readlane(inv, e);
            const v2u* orow = (const v2u*)(OB + ((size_t)(b * 16 + e) * CAP + c) * DM) + lane;
#pragma unroll
            for (int j = 0; j < 4; ++j) w[q][j] = orow[64 * j];
            n = q + 1; }
#pragma unroll
        for (int q = 0; q < 4; ++q) if (q < n) {
#pragma unroll
            for (int j = 0; j < 4; ++j) { v[j].x += bf2f(w[q][j].x & 0xffff); v[j].y += bf2f(w[q][j].x >> 16); v[j].z += bf2f(w[q][j].y & 0xffff); v[j].w += bf2f(w[q][j].y >> 16); } }
    }
}
__device__ __forceinline__ void p11_combine_norm(const Frame& F) {
    int tid = threadIdx.x; asm volatile("" : "+v"(tid)); const int lane = tid & 63;
    const KArgs ka = kargs();
    unsigned char* ws = F.ws; float* xo = ka->out; const int* INV = (const int*)(ws + WS_INV); const bf16* OB = (const bf16*)(ws + WS_OB); bf16* H = (bf16*)(ws + WS_HB);
    const float* g = (const float*)ka->in[19];
    f32x4 gg[4];
#pragma unroll
    for (int j = 0; j < 4; ++j) gg[j] = ((const f32x4*)g)[lane + 64 * j];
    for (int m0 = F.gw * 2; m0 < T; m0 += F.NGW * 2) {
        f32x4 va[4], vb[4];
        f32x4* xa = (f32x4*)(xo + (size_t)m0 * DM) + lane; f32x4* xb = xa + DM / 4;
        const int inva = INV[(size_t)m0 * 16 + (lane & 15)], invb = INV[(size_t)(m0 + 1) * 16 + (lane & 15)];
#pragma unroll
        for (int j = 0; j < 4; ++j) { va[j] = xa[64 * j]; vb[j] = xb[64 * j]; }
        const unsigned ma = (unsigned)(__ballot(inva >= 0) & 0xffffull), mb = (unsigned)(__ballot(invb >= 0) & 0xffffull);
        p11_row(OB, m0 >> 11, inva, ma, lane, va); p11_row(OB, m0 >> 11, invb, mb, lane, vb);
        float sa = 0.f, sb = 0.f;
#pragma unroll
        for (int j = 0; j < 4; ++j) { xa[64 * j] = va[j]; xb[64 * j] = vb[j]; sa += (va[j].x * va[j].x + va[j].y * va[j].y) + (va[j].z * va[j].z + va[j].w * va[j].w); sb += (vb[j].x * vb[j].x + vb[j].y * vb[j].y) + (vb[j].z * vb[j].z + vb[j].w * vb[j].w); }
        const float ra = 1.0f / sqrtf(wave_sum(sa) * (1.0f / DM) + EPS), rb = 1.0f / sqrtf(wave_sum(sb) * (1.0f / DM) + EPS);
        unsigned long long* oa = (unsigned long long*)(H + (size_t)m0 * DM) + lane; unsigned long long* ob = oa + DM / 4;
#pragma unroll
        for (int j = 0; j < 4; ++j) { const f32x4 ha = va[j] * ra * gg[j], hb = vb[j] * rb * gg[j];
            oa[64 * j] = (unsigned long long)pk2(ha.x, ha.y) | ((unsigned long long)pk2(ha.z, ha.w) << 32); ob[64 * j] = (unsigned long long)pk2(hb.x, hb.y) | ((unsigned long long)pk2(hb.z, hb.w) << 32); }
    }
}

__device__ __forceinline__ void p13_final_norm(const Frame& F) {
    int tid = threadIdx.x; asm volatile("" : "+v"(tid)); const int lane = tid & 63;
    const KArgs ka = kargs();
    float* xo = ka->out; const float* g = (const float*)ka->in[22];
    for (int m = F.gw; m < T; m += F.NGW) {
        f32x4* xr = (f32x4*)(xo + (size_t)m * DM) + lane; f32x4 v[4]; float s = 0.f;
#pragma unroll
        for (int j = 0; j < 4; ++j) { v[j] = xr[64 * j]; s += (v[j].x * v[j].x + v[j].y * v[j].y) + (v[j].z * v[j].z + v[j].w * v[j].w); }
        const float rstd = 1.0f / sqrtf(wave_sum(s) * (1.0f / DM) + EPS);
#pragma unroll
        for (int j = 0; j < 4; ++j) { const f32x4 gg = ((const f32x4*)g)[lane + 64 * j]; xr[64 * j] = v[j] * rstd * gg; }
    }
}

constexpr int LATE_SPLIT = LATE_OUT + LATE_G + LATE_G / 2;
#ifndef PHMASK
#define PHMASK 0x7ffff
#endif
#ifndef DBLMASK
#define DBLMASK 0
#endif
#ifdef STAMP_K
#define STAMP(i) do { if ((i) == STAMP_K - 1) ts0 = __builtin_amdgcn_s_memrealtime(); if ((i) == STAMP_K) ts1 = __builtin_amdgcn_s_memrealtime(); } while (0)
#else
#define STAMP(i) do { } while (0)
#endif
#define REP(bit) for (int rep_ = 0; rep_ < ((DBLMASK & (bit)) ? 2 : 1); ++rep_)
__global__ void __launch_bounds__(NWAVES * 64, 2) fwd_kernel(Args args) {
    extern __shared__ __attribute__((aligned(16))) unsigned char lds[];
    Frame F;
    F.lds = (char*)lds; F.tid = threadIdx.x; F.lane = F.tid & 63; F.wave = __builtin_amdgcn_readfirstlane(F.tid >> 6);
    F.G = gridDim.x; { const int bx = blockIdx.x; F.vcu = (F.G % 8 == 0) ? (bx % 8) * (F.G / 8) + bx / 8 : bx; }
    F.gw = F.vcu * NWAVES + F.wave; F.NGW = F.G * NWAVES; F.ws = args.ws;
    unsigned char* ws = args.ws;
    volatile LAS unsigned* MISC = (volatile LAS unsigned*)((LAS unsigned char*)lds + MISC_OFF);
    if (F.tid < 16) MISC[F.tid] = 0u;
    __syncthreads();
    XcdBarrier bar = xcd_barrier_post((unsigned*)(ws + WS_CTL) + CW_BAR, MISC + 8);
    PG8_LAS unsigned char* ring = (PG8_LAS unsigned char*)lds;
    const int G = F.G, bx = (int)blockIdx.x;

#ifdef STAMP_K
    unsigned long long ts0 = __builtin_amdgcn_s_memrealtime(), ts1 = 0;
#endif
    REP(1) if (PHMASK & 1) p0_prologue(F);
    xcd_barrier(bar); STAMP(0);
    REP(2) if (PHMASK & 2) { pg8::Gemm g{(const bf16*)(ws + WS_HB), (const bf16*)(ws + WS_WIN), T, IN_PAD, DM}; pg8::StaticOrder S; S.init(T, IN_PAD, G, bx);
      pg8::EpiZ E{ws};
      pg8::gemm_phase<pg8::EpiZ, pg8::StaticOrder, true, false>(ring, g, S, E);
      const int nu = S.nwg, rem = nu % G;
      if (rem == 0 || bx >= rem) { const int nid = rem == 0 ? G : G - rem, id = rem == 0 ? bx : bx - rem;
        { pg8::Gemm g2{(const bf16*)(ws + WS_PB), (const bf16*)(ws + WS_WPP), T, DM, PLE}; pg8::StaticOrder S2; S2.init(T, DM, nid, id);
          pg8::EpiBf<1024> E2{(bf16*)(ws + WS_PROJ)};
          pg8::gemm_phase<pg8::EpiBf<1024>, pg8::StaticOrder, true, false>(ring, g2, S2, E2); }
        convert_late_weights(F, 0, LATE_SPLIT, id * NWAVES + F.wave, nid * NWAVES); } }
    xcd_barrier(bar); STAMP(1);
    REP(8) if (PHMASK & 8) { pg8::Gemm g{(const bf16*)(ws + WS_CQN), (const bf16*)(ws + WS_WUQ), T, 768, 256}; pg8::StaticOrder S; S.init(T, 768, G, bx);
      pg8::EpiBf<768> E{(bf16*)(ws + WS_QB)};
      pg8::gemm_phase<pg8::EpiBf<768>, pg8::StaticOrder, true, false>(ring, g, S, E); }
    REP(0x20000) if (PHMASK & 0x20000) { pg8::Gemm g{(const bf16*)(ws + WS_CKVN), (const bf16*)(ws + WS_WUKV), T, 1024, 256}; pg8::StaticOrder S; S.init(T, 1024, G, bx);
      pg8::EpiBf<1024> E{(bf16*)(ws + WS_KVB)};
      pg8::gemm_phase<pg8::EpiBf<1024>, pg8::StaticOrder, true, false>(ring, g, S, E); }
    xcd_barrier(bar); STAMP(2);
    if (PHMASK & 16) { const bf16* QB = (const bf16*)(ws + WS_QB); const bf16* KVB = (const bf16*)(ws + WS_KVB); const bf16* KR = (const bf16*)(ws + WS_KR); bf16* Y = (bf16*)(ws + WS_Y);
      REP(16) for (int u = F.vcu; u < 512; u += G) { const int qb = u & 7, bh = u >> 3;
          att::mla::unit(bh >> 3, bh & 7, qb, QB, KVB, KR, (const float*)(ws + WS_COS), (const float*)(ws + WS_SIN), Y, (char*)lds); }
      REP(0x10000) if (PHMASK & 0x10000) for (int u = F.vcu; u < 512; u += G) { const int qb = u & 7, bh = u >> 3;
          att::wnd::unit(bh >> 3, bh & 7, qb, (const bf16*)(ws + WS_QA), (const bf16*)(ws + WS_KVA), (const float*)kargs()->in[3], (const float*)kargs()->in[6], Y, (char*)lds); } }
    xcd_barrier(bar); STAMP(3);
    if (PHMASK & 32) p5_group_norm(F);
    xcd_barrier(bar); STAMP(4);
    REP(64) if (PHMASK & 64) { pg8::Gemm g{(const bf16*)(ws + WS_Y), (const bf16*)(ws + WS_WOUT), T, DM, DM}; pg8::StaticOrder S; S.init(T, DM, G, bx);
      const KArgs ka = kargs(); pg8::EpiRes E{(const float*)ka->in[0], ka->out};
      pg8::gemm_phase<pg8::EpiRes, pg8::StaticOrder, true, false>(ring, g, S, E); }
    xcd_barrier(bar); STAMP(5);
    REP(128) if (PHMASK & 128) p7_ffn_norm_router(F);
    xcd_barrier(bar); STAMP(6);
    if (PHMASK & 256) { const int nsort = G / 2;
      if (bx < nsort) p8_topk(F, bx, nsort);
      else convert_late_weights(F, LATE_SPLIT, LATE_N, (bx - nsort) * NWAVES + F.wave, (G - nsort) * NWAVES); }
    xcd_barrier(bar); STAMP(7);
    REP(512) if (PHMASK & 512) { pg8::Gemm g{(const bf16*)(ws + WS_HB), (const bf16*)(ws + WS_WGU), NBE * CAP, 1024, DM}; pg8::StaticOrder S; S.init(NBE * CAP, 1024, G, bx); S.bexp = 16;
      PG8_LAS int* gtab = (PG8_LAS int*)((PG8_LAS unsigned char*)lds + XTRA_OFF); const int* SEL = (const int*)(ws + WS_SEL);
      { pg8::Unit u; for (int i = 0; i < 15 && S.next(i, u); ++i) if (F.tid < 256) gtab[i * 256 + F.tid] = (u.pm >> 4) * SEQ + SEL[u.pm * CAP + F.tid]; }
      __syncthreads();
      pg8::EpiSwiGLU E{(bf16*)(ws + WS_ACT)};
      pg8::gemm_phase<pg8::EpiSwiGLU, pg8::StaticOrder, true, true>(ring, g, S, E, gtab); }
    xcd_barrier(bar); STAMP(8);
    REP(1024) if (PHMASK & 1024) { pg8::Gemm g{(const bf16*)(ws + WS_ACT), (const bf16*)(ws + WS_WD), NBE * CAP, 1024, FF}; pg8::StaticOrder S; S.init(NBE * CAP, 1024, G, bx); S.bexp = 16;
      pg8::EpiDown E{(bf16*)(ws + WS_OB), (const float*)(ws + WS_VAL)};
      pg8::gemm_phase<pg8::EpiDown, pg8::StaticOrder, true, false>(ring, g, S, E); }
    xcd_barrier(bar); STAMP(9);
    if (PHMASK & 2048) p11_combine_norm(F);
    xcd_barrier(bar); STAMP(10);
    if (PHMASK & 0x40000) { pg8::Gemm g{(const bf16*)(ws + WS_HB), (const bf16*)(ws + WS_WPG), T, DM, DM}; pg8::StaticOrder S; S.init(T, DM, G, bx);
      pg8::EpiPle E{kargs()->out, (const bf16*)(ws + WS_PROJ)};
      pg8::gemm_phase<pg8::EpiPle, pg8::StaticOrder, true, false>(ring, g, S, E); }
    xcd_barrier(bar); STAMP(11);
    if (PHMASK & 8192) p13_final_norm(F);
#ifdef STAMP_K
    { const unsigned long long te = __builtin_amdgcn_s_memrealtime(); if (STAMP_K == 12) ts1 = te;
      if (blockIdx.x == 0) { const unsigned long long want = (ts1 - ts0) * STAMP_MULT; while (__builtin_amdgcn_s_memrealtime() - te < want) __builtin_amdgcn_s_sleep(8); } }
#endif
}

extern "C" void kernel_launch(void* const* d_in, const int* in_sizes, int n_in, void* d_out, int out_size, void* d_ws, size_t ws_size, hipStream_t stream) {
    static int grid = 0;
    if (grid == 0) {
        if (n_in != 23 || in_sizes[0] != T * DM || out_size != T * DM || ws_size < WS_END) { fprintf(stderr, "kernel_launch: unexpected shapes: n_in %d in0 %d out %d ws %zu (need %zu)\n", n_in, n_in > 0 ? in_sizes[0] : -1, out_size, ws_size, (size_t)WS_END); grid = -1; return; }
        int dev = 0, cus = 0, per_cu = 0;
        if (hipGetDevice(&dev) != hipSuccess || hipDeviceGetAttribute(&cus, hipDeviceAttributeMultiprocessorCount, dev) != hipSuccess) { fprintf(stderr, "kernel_launch: device query failed\n"); grid = -1; return; }
        if (hipFuncSetAttribute((const void*)fwd_kernel, hipFuncAttributeMaxDynamicSharedMemorySize, LDS_BYTES) != hipSuccess) { fprintf(stderr, "kernel_launch: hipFuncSetAttribute failed\n"); grid = -1; return; }
        if (hipOccupancyMaxActiveBlocksPerMultiprocessor(&per_cu, (const void*)fwd_kernel, NWAVES * 64, LDS_BYTES) != hipSuccess || per_cu < 1) { fprintf(stderr, "kernel_launch: occupancy query says %d workgroups per CU\n", per_cu); (void)hipGetLastError(); }
        grid = cus;
    }
    if (grid < 0) return;
    if (hipMemsetAsync((char*)d_ws + WS_CTL, 0, CTL_ZERO_BYTES, stream) != hipSuccess) { fprintf(stderr, "kernel_launch: hipMemsetAsync failed\n"); return; }
    Args a{};
    for (int i = 0; i < 23; ++i) a.in[i] = d_in[i];
    a.out = (float*)d_out; a.ws = (unsigned char*)d_ws;
    hipLaunchKernelGGL(fwd_kernel, dim3(grid), dim3(NWAVES * 64), LDS_BYTES, stream, a);
    const hipError_t le = hipPeekAtLastError();
    if (le != hipSuccess) fprintf(stderr, "kernel_launch: launch failed: %s\n", hipGetErrorName(le));
}
```
